# Optimizing an MI355X kernel written in HIP

```python
import jax, jax.numpy as jnp
from jax import lax
import numpy as np

D_MODEL = 1024
BATCH = 4
SEQ = 8192
DEPTH = 2

MIX_WIDTH = D_MODEL
BRANCH = MIX_WIDTH // 2
GLA_HEADS = 4
GLA_DK = BRANCH // 2 // GLA_HEADS
GLA_DV = BRANCH // GLA_HEADS
GLA_RANK = 16
GLA_TAU = 16.0
GLA_CHUNK = 64
SGU_GROUPS = 4
SGU_CHUNK = 128
SGU_CH = BRANCH // SGU_GROUPS
RET_HEADS = 4
RET_DK = BRANCH // 2 // RET_HEADS
RET_DV = BRANCH // RET_HEADS
RET_CHUNK = 128
ROPE_BASE = 10000.0
POOL_WINDOWS = (2, 4, 8, 16)
POOL_CH = BRANCH // len(POOL_WINDOWS)
DN_ALPHA = (2 * DEPTH) ** 0.25
DN_BETA = (8 * DEPTH) ** -0.25
LN_EPS = 1e-5

EVEN_SIZES = (GLA_HEADS * GLA_DK, GLA_HEADS * GLA_DK, BRANCH, BRANCH, GLA_RANK,
              BRANCH, BRANCH, BRANCH)
ODD_SIZES = (RET_HEADS * RET_DK, RET_HEADS * RET_DK, BRANCH, BRANCH,
             BRANCH, BRANCH)

kernel_name = "hybrid_gla_sgu_retention_pool_deepnorm"


def _split(h, sizes):
    idx = [int(i) for i in np.cumsum(sizes)[:-1]]
    return jnp.split(h, idx, axis=-1)


def _layer_norm(x, g, b):
    xf = x.astype(jnp.float32)
    mu = jnp.mean(xf, axis=-1, keepdims=True)
    var = jnp.mean(jnp.square(xf - mu), axis=-1, keepdims=True)
    return ((xf - mu) * lax.rsqrt(var + LN_EPS) * g + b).astype(x.dtype)


def _head_rmsnorm(o, g):
    of = o.astype(jnp.float32)
    return of * lax.rsqrt(jnp.mean(jnp.square(of), axis=-1, keepdims=True) + LN_EPS) * g


def _head_groupnorm(o, g):
    of = o.astype(jnp.float32)
    mu = jnp.mean(of, axis=-1, keepdims=True)
    var = jnp.mean(jnp.square(of - mu), axis=-1, keepdims=True)
    return (of - mu) * lax.rsqrt(var + LN_EPS) * g


def _chunk_scan(decay, chunk_state):
    def step(s_prev, inp):
        dec, cs = inp
        return dec * s_prev + cs, s_prev
    init = jnp.zeros(chunk_state.shape[1:], jnp.float32)
    _, s_in = lax.scan(step, init, (decay, chunk_state))
    return s_in


def _gla(q, k, v, log_a):
    B, S, H, dk = q.shape
    dv = v.shape[-1]
    C = GLA_CHUNK
    n = S // C
    f32 = jnp.float32
    q = q.astype(f32).reshape(B, n, C, H, dk) * (dk ** -0.5)
    k = k.astype(f32).reshape(B, n, C, H, dk)
    v = v.astype(f32).reshape(B, n, C, H, dv)
    b = jnp.cumsum(log_a.astype(f32).reshape(B, n, C, H, dk), axis=2)
    q_dec = q * jnp.exp(b)
    k_dec = k * jnp.exp(-b)
    causal = jnp.tril(jnp.ones((C, C), dtype=bool))
    scores = jnp.einsum('bnihd,bnjhd->bnhij', q_dec, k_dec)
    scores = jnp.where(causal, scores, 0.0)
    o_intra = jnp.einsum('bnhij,bnjhe->bnihe', scores, v)
    b_last = b[:, :, -1]
    k_state = k * jnp.exp(b_last[:, :, None] - b)
    chunk_state = jnp.einsum('bnjhd,bnjhe->bnhde', k_state, v)
    decay = jnp.exp(b_last)[..., None]
    s_in = _chunk_scan(jnp.moveaxis(decay, 1, 0), jnp.moveaxis(chunk_state, 1, 0))
    s_in = jnp.moveaxis(s_in, 0, 1)
    o_inter = jnp.einsum('bnihd,bnhde->bnihe', q_dec, s_in)
    return (o_intra + o_inter).reshape(B, S, H, dv)


def _spatial_gating(u, sv, ln_g, ln_b, w_s, b_s):
    B, S, _ = u.shape
    n = S // SGU_CHUNK
    svr = sv.reshape(B, n, SGU_CHUNK, SGU_GROUPS, SGU_CH)
    svr = _layer_norm(svr, ln_g, ln_b)
    w = jnp.where(jnp.tril(jnp.ones((SGU_CHUNK, SGU_CHUNK), dtype=bool)), w_s, 0.0)
    s = jnp.einsum('gts,bnsgc->bntgc', w, svr) + jnp.transpose(b_s)[None, None, :, :, None]
    return u * s.reshape(B, S, BRANCH).astype(u.dtype)


def _rotary(x, positions):
    half = x.shape[-1] // 2
    inv = ROPE_BASE ** (-jnp.arange(half, dtype=jnp.float32) / half)
    ang = positions.astype(jnp.float32)[..., None] * inv
    cos = jnp.cos(ang)[:, :, None, :]
    sin = jnp.sin(ang)[:, :, None, :]
    xf = x.astype(jnp.float32)
    x1, x2 = xf[..., :half], xf[..., half:]
    return jnp.concatenate([x1 * cos - x2 * sin, x1 * sin + x2 * cos], axis=-1)


def _retention(q, k, v):
    B, S, H, dk = q.shape
    dv = v.shape[-1]
    C = RET_CHUNK
    n = S // C
    f32 = jnp.float32
    log_gamma = jnp.log(1.0 - 2.0 ** (-5.0 - jnp.arange(H, dtype=f32)))
    q = q.astype(f32).reshape(B, n, C, H, dk) * (dk ** -0.5)
    k = k.astype(f32).reshape(B, n, C, H, dk)
    v = v.astype(f32).reshape(B, n, C, H, dv)
    idx = jnp.arange(C, dtype=f32)
    rel = idx[:, None] - idx[None, :]
    dmat = jnp.where(rel >= 0, jnp.exp(jnp.maximum(rel, 0.0)[None] * log_gamma[:, None, None]), 0.0)
    scores = jnp.einsum('bnihd,bnjhd->bnhij', q, k) * dmat
    o_intra = jnp.einsum('bnhij,bnjhe->bnihe', scores, v)
    w_state = jnp.exp((C - 1.0 - idx)[None] * log_gamma[:, None])
    chunk_state = jnp.einsum('bnjhd,hj,bnjhe->bnhde', k, w_state, v)
    chunk_decay = jnp.exp(C * log_gamma)[None, None, :, None, None]
    chunk_decay = jnp.broadcast_to(chunk_decay, (B, n, H, 1, 1))
    s_in = _chunk_scan(jnp.moveaxis(chunk_decay, 1, 0), jnp.moveaxis(chunk_state, 1, 0))
    s_in = jnp.moveaxis(s_in, 0, 1)
    w_inter = jnp.exp((idx + 1.0)[None] * log_gamma[:, None])
    o_inter = jnp.einsum('bnihd,hi,bnhde->bnihe', q, w_inter, s_in)
    return (o_intra + o_inter).reshape(B, S, H, dv)


def _multiscale_pool(p, w_pool, scale):
    B, S, _ = p.shape
    pf = p.astype(jnp.float32)
    cs = jnp.concatenate([jnp.zeros((B, 1, BRANCH), jnp.float32), jnp.cumsum(pf, axis=1)], axis=1)
    t = jnp.arange(S)
    outs = []
    for g, w in enumerate(POOL_WINDOWS):
        lo, hi = g * POOL_CH, (g + 1) * POOL_CH
        start = jnp.maximum(t + 1 - w, 0)
        win_sum = cs[:, 1:, lo:hi] - cs[:, start, lo:hi]
        cnt = jnp.minimum(t + 1, w).astype(jnp.float32)[None, :, None]
        outs.append(win_sum / cnt - pf[..., lo:hi])
    pooled = jnp.concatenate(outs, axis=-1).reshape(B, S, len(POOL_WINDOWS), POOL_CH)
    y = jnp.einsum('bsgc,gcd->bsgd', pooled, w_pool).reshape(B, S, BRANCH) * scale
    return y.astype(p.dtype)


def _even_layer(x, w_in, w_a2, b_a, gla_norm_g, sgu_ln_g, sgu_ln_b, w_s, b_s, w_out, ln_g, ln_b):
    B, S, _ = x.shape
    h = x @ w_in
    q, k, v, g_a, a_lr, u, sv, g_b = _split(h, EVEN_SIZES)
    log_a = jax.nn.log_sigmoid((a_lr @ w_a2 + b_a).astype(jnp.float32)) / GLA_TAU
    o = _gla(q.reshape(B, S, GLA_HEADS, GLA_DK), k.reshape(B, S, GLA_HEADS, GLA_DK),
             v.reshape(B, S, GLA_HEADS, GLA_DV), log_a.reshape(B, S, GLA_HEADS, GLA_DK))
    o_a = _head_rmsnorm(o, gla_norm_g).reshape(B, S, BRANCH).astype(x.dtype) * jax.nn.silu(g_a)
    o_b = _spatial_gating(jax.nn.gelu(u), jax.nn.gelu(sv), sgu_ln_g, sgu_ln_b, w_s, b_s) * jax.nn.silu(g_b)
    y = jnp.concatenate([o_a, o_b], axis=-1) @ w_out
    return _layer_norm(DN_ALPHA * x + y, ln_g, ln_b)


def _odd_layer(x, positions, w_in, ret_norm_g, w_pool, pool_scale, w_out, ln_g, ln_b):
    B, S, _ = x.shape
    h = x @ w_in
    q, k, v, g_c, p, g_d = _split(h, ODD_SIZES)
    qr = _rotary(q.reshape(B, S, RET_HEADS, RET_DK), positions)
    kr = _rotary(k.reshape(B, S, RET_HEADS, RET_DK), positions)
    o = _retention(qr, kr, v.reshape(B, S, RET_HEADS, RET_DV))
    o_c = _head_groupnorm(o, ret_norm_g).reshape(B, S, BRANCH).astype(x.dtype) * jax.nn.silu(g_c)
    o_d = _multiscale_pool(p, w_pool, pool_scale) * jax.nn.silu(g_d)
    y = jnp.concatenate([o_c, o_d], axis=-1) @ w_out
    return _layer_norm(DN_ALPHA * x + y, ln_g, ln_b)


def setup_inputs(seed: int = 0) -> dict:
    key = jax.random.key(seed)
    ks = jax.random.split(key, 24)
    f32 = jnp.float32
    nrm = lambda k, shape, s: jax.random.normal(k, shape, f32) * s
    d_even = sum(EVEN_SIZES)
    d_odd = sum(ODD_SIZES)
    return {
        "x": jax.random.normal(ks[0], (BATCH, SEQ, D_MODEL), f32),
        "positions": jnp.broadcast_to(jnp.arange(SEQ, dtype=jnp.int32), (BATCH, SEQ)),
        "l0_w_in": nrm(ks[1], (D_MODEL, d_even), D_MODEL ** -0.5),
        "l0_w_a2": nrm(ks[2], (GLA_RANK, GLA_HEADS * GLA_DK), GLA_RANK ** -0.5),
        "l0_b_a": nrm(ks[3], (GLA_HEADS * GLA_DK,), 0.1),
        "l0_gla_norm_g": 1.0 + nrm(ks[4], (GLA_HEADS, GLA_DV), 0.1),
        "l0_sgu_ln_g": 1.0 + nrm(ks[5], (SGU_GROUPS, SGU_CH), 0.1),
        "l0_sgu_ln_b": nrm(ks[6], (SGU_GROUPS, SGU_CH), 0.02),
        "l0_w_s": nrm(ks[7], (SGU_GROUPS, SGU_CHUNK, SGU_CHUNK), 0.5 * SGU_CHUNK ** -0.5),
        "l0_b_s": 1.0 + nrm(ks[8], (SGU_GROUPS, SGU_CHUNK), 0.1),
        "l0_w_out": nrm(ks[9], (MIX_WIDTH, D_MODEL), DN_BETA * MIX_WIDTH ** -0.5),
        "l0_ln_g": 1.0 + nrm(ks[10], (D_MODEL,), 0.1),
        "l0_ln_b": nrm(ks[11], (D_MODEL,), 0.02),
        "l1_w_in": nrm(ks[12], (D_MODEL, d_odd), D_MODEL ** -0.5),
        "l1_ret_norm_g": 1.0 + nrm(ks[13], (RET_HEADS, RET_DV), 0.1),
        "l1_w_pool": nrm(ks[14], (len(POOL_WINDOWS), POOL_CH, POOL_CH), POOL_CH ** -0.5),
        "l1_pool_scale": 0.5 + nrm(ks[15], (BRANCH,), 0.05),
        "l1_w_out": nrm(ks[16], (MIX_WIDTH, D_MODEL), DN_BETA * MIX_WIDTH ** -0.5),
        "l1_ln_g": 1.0 + nrm(ks[17], (D_MODEL,), 0.1),
        "l1_ln_b": nrm(ks[18], (D_MODEL,), 0.02),
    }


def reference(x, positions, l0_w_in, l0_w_a2, l0_b_a, l0_gla_norm_g, l0_sgu_ln_g, l0_sgu_ln_b,
              l0_w_s, l0_b_s, l0_w_out, l0_ln_g, l0_ln_b, l1_w_in, l1_ret_norm_g, l1_w_pool,
              l1_pool_scale, l1_w_out, l1_ln_g, l1_ln_b):
    even_params = [(l0_w_in, l0_w_a2, l0_b_a, l0_gla_norm_g, l0_sgu_ln_g, l0_sgu_ln_b,
                    l0_w_s, l0_b_s, l0_w_out, l0_ln_g, l0_ln_b)]
    odd_params = [(l1_w_in, l1_ret_norm_g, l1_w_pool, l1_pool_scale, l1_w_out, l1_ln_g, l1_ln_b)]
    for layer in range(DEPTH):
        if layer % 2 == 0:
            x = _even_layer(x, *even_params[layer // 2])
        else:
            x = _odd_layer(x, positions, *odd_params[layer // 2])
    return x
```

```cpp
#include <hip/hip_runtime.h>
#include <hip/hip_cooperative_groups.h>
#include <cstdio>
namespace pg8 {
#define PG8_LAS __attribute__((address_space(3)))
typedef unsigned short bf16_t;
typedef short bf16x8 __attribute__((ext_vector_type(8)));
typedef float f32x4 __attribute__((ext_vector_type(4)));
typedef unsigned u32x4 __attribute__((ext_vector_type(4)));
constexpr int BM = 256, BK = 64, HALF = 128, HTB = HALF * BK * 2  , STAGE_BYTES = 8 * HTB, NXCD = 8, WGM = 8;

__host__ __device__ __forceinline__ int lds_byte(int r, int c) { const int st = (r >> 4) * 2 + (c >> 5), rr = r & 15, cc = c & 31, ob = rr * 64 + cc * 2; return st * 1024 + (ob ^ (((ob >> 9) & 1) << 5)); }
__host__ __device__ __forceinline__ void stage_rc(int b, int& R, int& C) { const int st = b / 1024, sb = b % 1024, swz = sb ^ (((sb >> 9) & 1) << 5); R = (st >> 1) * 16 + swz / 64; C = (st & 1) * 32 + (swz % 64) / 2; }
__host__ __device__ __forceinline__ int perm32(int rho) { const int n = rho >> 4, i = rho & 15; return 8 * (i >> 2) + 4 * n + (i & 3); }

struct Unit { int pm, pn; };
struct Gemm { const bf16_t* A; const bf16_t* Bt; int M, N, K; };

struct StaticOrder {
    int nM, nN, nwg, G, c;
    __host__ __device__ void init(int M, int N, int G_, int c_) { nM = M / BM; nN = N / BM; nwg = nM * nN; G = G_; c = c_; }
    __host__ __device__ bool next(int i, Unit& u) const {
        const long L = (long)i * G + c; if (L >= nwg) return false;
        int wgid = (int)L; { const int q = nwg / NXCD, r = nwg % NXCD, xcd = wgid % NXCD, off = wgid / NXCD; wgid = (xcd < r ? xcd * (q + 1) : r * (q + 1) + (xcd - r) * q) + off; }
        const int nig = WGM * nN, gid = wgid / nig, fm = gid * WGM, gsz = (nM - fm) < WGM ? (nM - fm) : WGM;
        u.pm = fm + ((wgid % nig) % gsz); u.pn = (wgid % nig) / gsz; return true;
    }
    __device__ __forceinline__ void a_ready(const Unit&) const {}
    __device__ __forceinline__ void done(const Unit&) const {}
};
struct CountedOrder : StaticOrder {
    const unsigned* ready; unsigned need; unsigned* tmo;
    __device__ __forceinline__ void a_ready(const Unit& u) const {
        if (threadIdx.x < 64) {
            const unsigned long long t0 = __builtin_amdgcn_s_memrealtime(); unsigned polls = 0;
            while ((unsigned)__builtin_amdgcn_readfirstlane(__hip_atomic_load(ready + 64 * u.pm, __ATOMIC_RELAXED, __HIP_MEMORY_SCOPE_AGENT)) < need) {
                if ((++polls & 255u) == 0u && __builtin_amdgcn_readfirstlane(__hip_atomic_load(tmo, __ATOMIC_RELAXED, __HIP_MEMORY_SCOPE_AGENT)) != 0u) break;
                if (__builtin_amdgcn_s_memrealtime() - t0 > 2000000ull) {
                    if (threadIdx.x == 0) { unsigned expect = 0u; __hip_atomic_compare_exchange_strong(tmo + 1, &expect, 0x600u | (unsigned)(u.pm & 0xff), __ATOMIC_RELAXED, __ATOMIC_RELAXED, __HIP_MEMORY_SCOPE_AGENT); __hip_atomic_store(tmo, 1u, __ATOMIC_RELAXED, __HIP_MEMORY_SCOPE_AGENT); }
                    break; }
                __builtin_amdgcn_s_sleep(2); }
            __builtin_amdgcn_fence(__ATOMIC_ACQUIRE, "agent");
            asm volatile("s_waitcnt vmcnt(0)" ::: "memory");
        }
#if !defined(BROKEN_HOOK_NO_BARRIER)
        asm volatile("" ::: "memory"); __builtin_amdgcn_s_barrier(); asm volatile("" ::: "memory");
#endif
    }
};

__device__ __forceinline__ unsigned cvt_pk_bf16(float lo, float hi) { unsigned r; asm volatile("v_cvt_pk_bf16_f32 %0, %1, %2" : "=v"(r) : "v"(lo), "v"(hi)); return r; }
typedef float f32x2 __attribute__((ext_vector_type(2)));
__device__ __forceinline__ f32x2 gelu_pk(f32x2 v) {
    const f32x2 av = __builtin_elementwise_abs(v), d = av * 0.2316418882f + 1.0f;
    f32x2 t; t.x = __builtin_amdgcn_rcpf(d.x); t.y = __builtin_amdgcn_rcpf(d.y);
    f32x2 q = t * 0.5307027145f + (-0.7265760135f); q = q * t + 0.7107068705f; q = q * t + (-0.142248368f); q = q * t + 0.127414796f; q = q * t;
    const f32x2 s = (v * v) * (-0.72134752044f);
    f32x2 e; e.x = __builtin_amdgcn_exp2f(s.x); e.y = __builtin_amdgcn_exp2f(s.y);
    const f32x2 m = v * (q * e), r = v - m;
    f32x2 o; o.x = v.x < 0.f ? m.x : r.x; o.y = v.y < 0.f ? m.y : r.y; return o;
}

struct EpiF32 {
    static constexpr bool PERM = false, AFTER_DRAIN = false;
    float* C; int ldc; const float* bias;
    __device__ __forceinline__ void operator()(const f32x4 (&acc)[2][2][4][2], const Unit& u, int wr, int wc, int fr, int fq) const {
        const int row0 = u.pm * BM + wr * 64 + fr, col0 = u.pn * BM + wc * 32 + 4 * fq;
        f32x4 bv[2][2];
#pragma unroll
        for (int bj = 0; bj < 2; ++bj)
#pragma unroll
            for (int n = 0; n < 2; ++n) bv[bj][n] = bias ? *(const f32x4*)(bias + col0 + bj * HALF + n * 16) : (f32x4){0.f, 0.f, 0.f, 0.f};
#pragma unroll
        for (int ai = 0; ai < 2; ++ai)
#pragma unroll
            for (int m = 0; m < 4; ++m) { float* rowp = C + (size_t)(row0 + ai * HALF + m * 16) * ldc + col0;
#pragma unroll
                for (int bj = 0; bj < 2; ++bj)
#pragma unroll
                    for (int n = 0; n < 2; ++n) *(f32x4*)(rowp + bj * HALF + n * 16) = acc[ai][bj][m][n] + bv[bj][n]; }
    }
};
template <int ACT  > struct EpiBf16 {
    static constexpr bool PERM = true, AFTER_DRAIN = false;
    bf16_t* O; int ldc; const float* bias; int split_cols; size_t split_stride;
    __device__ __forceinline__ void operator()(const f32x4 (&acc)[2][2][4][2], const Unit& u, int wr, int wc, int fr, int fq) const {
        const int row0 = u.pm * BM + wr * 64 + fr; int colt = u.pn * BM; bf16_t* base = O;
        if (split_cols) { const int t = colt / split_cols; base += (size_t)t * split_stride; colt -= t * split_cols; }
        const int col0 = colt + wc * 32 + 8 * fq, bcol0 = u.pn * BM + wc * 32 + 8 * fq;
        f32x4 bv[2][2];
#pragma unroll
        for (int bj = 0; bj < 2; ++bj)
#pragma unroll
            for (int n = 0; n < 2; ++n) bv[bj][n] = bias ? *(const f32x4*)(bias + bcol0 + bj * HALF + 4 * n) : (f32x4){0.f, 0.f, 0.f, 0.f};
#pragma unroll
        for (int ai = 0; ai < 2; ++ai)
#pragma unroll
            for (int m = 0; m < 4; ++m) { bf16_t* rowp = base + (size_t)(row0 + ai * HALF + m * 16) * ldc + col0;
#pragma unroll
                for (int bj = 0; bj < 2; ++bj) { f32x4 v0 = acc[ai][bj][m][0] + bv[bj][0], v1 = acc[ai][bj][m][1] + bv[bj][1];
                    if (ACT == 1) { f32x2 a = gelu_pk((f32x2){v0[0], v0[1]}), b = gelu_pk((f32x2){v0[2], v0[3]}), c = gelu_pk((f32x2){v1[0], v1[1]}), d = gelu_pk((f32x2){v1[2], v1[3]});
                        v0 = (f32x4){a.x, a.y, b.x, b.y}; v1 = (f32x4){c.x, c.y, d.x, d.y}; }
                    if (ACT == 2) {
#pragma unroll
                        for (int j = 0; j < 4; ++j) { v0[j] = 0.5f * v0[j] * (1.0f + erff(v0[j] * 0.70710678f)); v1[j] = 0.5f * v1[j] * (1.0f + erff(v1[j] * 0.70710678f)); } }
                    u32x4 w; w.x = cvt_pk_bf16(v0[0], v0[1]); w.y = cvt_pk_bf16(v0[2], v0[3]); w.z = cvt_pk_bf16(v1[0], v1[1]); w.w = cvt_pk_bf16(v1[2], v1[3]);
                    *(u32x4*)(rowp + bj * HALF) = w; } }
    }
};

template <class Epi, class Sched, bool STAMP = false>
__device__ __forceinline__ void gemm_phase(PG8_LAS unsigned char* lds, const Gemm g, const Sched& S, const Epi& E, unsigned long long* stamps, int tid_in) {
    int tid_ = tid_in; asm volatile("" : "+v"(tid_)); const int tid = tid_, wid = __builtin_amdgcn_readfirstlane(tid >> 6), lane = tid & 63, wr = wid >> 2, wc = wid & 3, fr = lane & 15, fq = lane >> 4;
    const int K = g.K, nt = K / BK;
    int ts_lo = 0, ts_hi = 0, nts = 0; const unsigned long long rt_entry = STAMP ? (unsigned long long)wall_clock64() : 0ull;
#define PG8_STAMP() do { if (STAMP && wid == 0 && nts < 64) { const unsigned long long _c = (unsigned long long)clock64(); \
        ts_lo = (lane == nts) ? (int)(unsigned)_c : ts_lo; ts_hi = (lane == nts) ? (int)(unsigned)(_c >> 32) : ts_hi; ++nts; } } while (0)
    PG8_STAMP();
    unsigned voffA[2], voffB[2];
#pragma unroll
    for (int i = 0; i < 2; ++i) { int R, C; stage_rc(tid * 16 + i * 8192, R, C); const int Rb = Epi::PERM ? ((R & ~31) + perm32(R & 31)) : R;
        voffA[i] = (unsigned)(R * K + C) * 2u; voffB[i] = (unsigned)(Rb * K + C) * 2u; }
    const size_t kstep = (size_t)(BK * 2);
    const size_t hstep = (size_t)HALF * K * 2;
    const size_t tstep = 2 * hstep;
    const unsigned ldsw = (unsigned)wid * 1024u;
    const int aoff = lds_byte(wr * 64 + fr, fq * 8), boff = lds_byte(wc * 32 + fr, fq * 8);
#define PG8_SA(b, h) (((b) * 2 + (h)) * HTB)
#define PG8_SB(b, h) ((4 + (b) * 2 + (h)) * HTB)
#define PG8_STAGE(bufoff, gbase, voff) do { _Pragma("unroll") for (int _i = 0; _i < 2; ++_i) \
        __builtin_amdgcn_global_load_lds((const unsigned*)((const char*)(gbase) + (voff)[_i]), (PG8_LAS unsigned*)(lds + (bufoff) + ldsw + _i * 8192), 16, 0, 0); } while (0)
#define PG8_LDA(dst, b, h) do { _Pragma("unroll") for (int m = 0; m < 4; ++m) _Pragma("unroll") for (int k = 0; k < 2; ++k) dst[m][k] = *(const PG8_LAS bf16x8*)(lds + PG8_SA(b, h) + aoff + m * 2048 + k * 1024); } while (0)
#define PG8_LDB(dst, b, h) do { _Pragma("unroll") for (int n = 0; n < 2; ++n) _Pragma("unroll") for (int k = 0; k < 2; ++k) dst[n][k] = *(const PG8_LAS bf16x8*)(lds + PG8_SB(b, h) + boff + n * 2048 + k * 1024); } while (0)
#define PG8_MMA(ai, bj, At, Bt) do { __builtin_amdgcn_s_setprio(1); _Pragma("unroll") for (int m = 0; m < 4; ++m) _Pragma("unroll") for (int n = 0; n < 2; ++n) _Pragma("unroll") for (int k = 0; k < 2; ++k) \
        acc[ai][bj][m][n] = __builtin_amdgcn_mfma_f32_16x16x32_bf16(Bt[n][k], At[m][k], acc[ai][bj][m][n], 0, 0, 0); __builtin_amdgcn_s_setprio(0); } while (0)
#define PG8_WAIT_V(n) asm volatile("s_waitcnt vmcnt(" #n ")" ::: "memory")
#define PG8_WAIT_L(n) asm volatile("s_waitcnt lgkmcnt(" #n ")" ::: "memory")
#define PG8_BAR __builtin_amdgcn_s_barrier()
#define PG8_SCHED __builtin_amdgcn_sched_barrier(0)
    Unit cur, nxt; int ui = 0;
    if (!S.next(0, cur)) return;
    f32x4 acc[2][2][4][2];
#pragma unroll
    for (int a = 0; a < 2; ++a)
#pragma unroll
        for (int b = 0; b < 2; ++b)
#pragma unroll
            for (int m = 0; m < 4; ++m)
#pragma unroll
                for (int n = 0; n < 2; ++n) acc[a][b][m][n] = (f32x4){0.f, 0.f, 0.f, 0.f};
    bf16x8 At[4][2], B0[2][2], B1[2][2];
    const char* cA = (const char*)g.A + (size_t)cur.pm * tstep; const char* cB = (const char*)g.Bt + (size_t)cur.pn * tstep;
    S.a_ready(cur);
    PG8_STAGE(PG8_SB(0, 0), cB, voffB); PG8_STAGE(PG8_SA(0, 0), cA, voffA); PG8_STAGE(PG8_SB(0, 1), cB + hstep, voffB); PG8_STAGE(PG8_SA(0, 1), cA + hstep, voffA);
    if (wr == 1) PG8_BAR;
    PG8_WAIT_V(4); PG8_BAR;
    PG8_STAGE(PG8_SB(1, 0), cB + kstep, voffB); PG8_STAGE(PG8_SA(1, 0), cA + kstep, voffA); PG8_STAGE(PG8_SB(1, 1), cB + hstep + kstep, voffB);
    PG8_WAIT_V(6); PG8_BAR;
    PG8_STAMP();
    for (;;) {
        const bool has_next = S.next(ui + 1, nxt);
        const char* nA = has_next ? (const char*)g.A + (size_t)nxt.pm * tstep : cA; const char* nB = has_next ? (const char*)g.Bt + (size_t)nxt.pn * tstep : cB;
        for (int t = 0; t < nt; t += 2) {
            const bool last = (t == nt - 2);
            const char* a1 = cA + (size_t)(t + 1) * kstep;
            const char* a2 = last ? nA : cA + (size_t)(t + 2) * kstep; const char* b2 = last ? nB : cB + (size_t)(t + 2) * kstep;
            const char* a3 = a2 + kstep; const char* b3 = b2 + kstep;
            if (last && has_next) S.a_ready(nxt);
            PG8_LDB(B0, 0, 0); PG8_SCHED; PG8_LDA(At, 0, 0); PG8_STAGE(PG8_SA(1, 1), a1 + hstep, voffA);
            PG8_WAIT_L(8); PG8_BAR; PG8_WAIT_L(0); PG8_MMA(0, 0, At, B0); PG8_BAR; PG8_SCHED;
            PG8_LDB(B1, 0, 1); PG8_STAGE(PG8_SB(0, 0), b2, voffB);
            PG8_BAR; PG8_WAIT_L(0); PG8_MMA(0, 1, At, B1); PG8_BAR;
            PG8_LDA(At, 0, 1); PG8_STAGE(PG8_SA(0, 0), a2, voffA);
            PG8_BAR; PG8_WAIT_L(0); PG8_MMA(1, 0, At, B0); PG8_BAR; PG8_SCHED;
            PG8_STAGE(PG8_SB(0, 1), b2 + hstep, voffB);
            PG8_WAIT_V(6); PG8_BAR; PG8_MMA(1, 1, At, B1); PG8_BAR;
            PG8_LDB(B0, 1, 0); PG8_SCHED; PG8_LDA(At, 1, 0); PG8_STAGE(PG8_SA(0, 1), a2 + hstep, voffA);
            PG8_WAIT_L(8); PG8_BAR; PG8_WAIT_L(0); PG8_MMA(0, 0, At, B0); PG8_BAR; PG8_SCHED;
            PG8_LDB(B1, 1, 1); PG8_STAGE(PG8_SB(1, 0), b3, voffB);
            PG8_BAR; PG8_WAIT_L(0); PG8_MMA(0, 1, At, B1); PG8_BAR;
            PG8_LDA(At, 1, 1); PG8_STAGE(PG8_SA(1, 0), a3, voffA);
            PG8_BAR; PG8_WAIT_L(0); PG8_MMA(1, 0, At, B0); PG8_BAR; PG8_SCHED;
            PG8_STAGE(PG8_SB(1, 1), b3 + hstep, voffB);
            PG8_WAIT_V(6); PG8_BAR; PG8_MMA(1, 1, At, B1); PG8_BAR;
        }
        PG8_STAMP();
        if constexpr (!Epi::AFTER_DRAIN) { E(acc, cur, wr, wc, fr, fq); S.done(cur); }
        PG8_STAMP();
        if (!has_next) break;
#pragma unroll
        for (int a = 0; a < 2; ++a)
#pragma unroll
            for (int b = 0; b < 2; ++b)
#pragma unroll
                for (int m = 0; m < 4; ++m)
#pragma unroll
                    for (int n = 0; n < 2; ++n) acc[a][b][m][n] = (f32x4){0.f, 0.f, 0.f, 0.f};
        cur = nxt; cA = nA; cB = nB; ++ui;
    }
    PG8_WAIT_V(0);
    if (wr == 0) PG8_BAR;
    PG8_BAR;
    if constexpr (Epi::AFTER_DRAIN) { E.fused(acc, cur, wr, wc, fr, fq, lds, wid, lane); S.done(cur); }
    PG8_STAMP();
    if (STAMP && wid == 0) { stamps[lane] = lane < nts ? (((unsigned long long)(unsigned)ts_hi << 32) | (unsigned)ts_lo) : 0ull;
        if (lane == 62) stamps[62] = rt_entry; if (lane == 63) stamps[63] = (unsigned long long)wall_clock64(); }
#undef PG8_STAMP
#undef PG8_SA
#undef PG8_SB
#undef PG8_STAGE
#undef PG8_LDA
#undef PG8_LDB
#undef PG8_MMA
#undef PG8_WAIT_V
#undef PG8_WAIT_L
#undef PG8_BAR
#undef PG8_SCHED
}
}

namespace cg = cooperative_groups;
typedef unsigned short bf16_t;
typedef short bf16x8 __attribute__((ext_vector_type(8)));
typedef short bf16x4 __attribute__((ext_vector_type(4)));
typedef float f32x4 __attribute__((ext_vector_type(4)));
typedef unsigned u32x4 __attribute__((ext_vector_type(4)));
typedef unsigned u32x2 __attribute__((ext_vector_type(2)));

constexpr int NB = 4, SEQ = 8192, DM = 1024, MTOK = NB * SEQ;
constexpr int LDH0 = 3072, LDH1 = 2560;
constexpr int N0PAD = 3328;
constexpr float LN_EPS = 1e-5f;
constexpr float DN_ALPHA = 1.41421356237f;
constexpr int LDS_BYTES = 140 * 1024;

constexpr size_t WS_W0T = 0;
constexpr size_t WS_WO0T = WS_W0T + (size_t)N0PAD * 1024 * 2;
constexpr size_t WS_W1T = WS_WO0T + (size_t)1024 * 1024 * 2;
constexpr size_t WS_WO1T = WS_W1T + (size_t)2560 * 1024 * 2;
constexpr size_t WS_COS = WS_WO1T + (size_t)1024 * 1024 * 2;
constexpr size_t WS_SIN = WS_COS + (size_t)MTOK * 32 * 4;
constexpr size_t WS_ALR = WS_SIN + (size_t)MTOK * 32 * 4;
constexpr size_t WS_DEC = WS_ALR + (size_t)MTOK * 16 * 4;
constexpr size_t WS_XB = WS_DEC + (size_t)16 * 128 * 64 * 4;
constexpr size_t WS_H = WS_XB + (size_t)MTOK * 1024 * 2;
constexpr size_t WS_UT = WS_H + (size_t)MTOK * LDH0 * 2;
constexpr size_t WS_ST = WS_UT + (size_t)16 * 128 * 128 * 64 * 4;
constexpr size_t WS_MIX = WS_ST + (size_t)16 * 128 * 128 * 64 * 2;
constexpr size_t WS_END = WS_MIX + (size_t)MTOK * 1024 * 2;

struct Params { const float* in[20]; float* out; unsigned char* ws; };

__device__ __forceinline__ float bf2f(bf16_t b) { return __uint_as_float(((unsigned)b) << 16); }
__device__ __forceinline__ bf16_t f2bf(float f) { unsigned u = __float_as_uint(f); u += 0x7FFFu + ((u >> 16) & 1u); return (bf16_t)(u >> 16); }
__device__ __forceinline__ unsigned pk2(float lo, float hi) { unsigned r; asm("v_cvt_pk_bf16_f32 %0, %1, %2" : "=v"(r) : "v"(lo), "v"(hi)); return r; }
__device__ __forceinline__ float lo16(unsigned w) { return __uint_as_float(w << 16); }
__device__ __forceinline__ float hi16(unsigned w) { return __uint_as_float(w & 0xffff0000u); }
__device__ __forceinline__ float silu_f(float x) { return x * __builtin_amdgcn_rcpf(1.0f + __expf(-x)); }
__device__ __forceinline__ float gelu_f(float x) { const float u = 1.5957691216f * (x + 0.044715f * x * x * x); return x * __builtin_amdgcn_rcpf(1.0f + __expf(-u)); }
__device__ __forceinline__ unsigned lds_addr(const void* p) { return (unsigned)(size_t)p; }
__device__ __forceinline__ float wave_sum(float v) {
#pragma unroll
    for (int o = 32; o >= 1; o >>= 1) v += __shfl_xor(v, o);
    return v;
}
__device__ __forceinline__ bf16x8 lds_tr_frag(unsigned base, int stride, int k0, int col0, int lane) {
    const int g = lane >> 4, q = (lane & 15) >> 2, p = lane & 3;
    const unsigned a0 = base + (unsigned)((k0 + 8 * g + q) * stride + (col0 + 4 * p) * 2);
    const unsigned a1 = a0 + (unsigned)(4 * stride);
    bf16x4 lo, hi;
    asm volatile("ds_read_b64_tr_b16 %0, %2\n\tds_read_b64_tr_b16 %1, %3\n\ts_waitcnt lgkmcnt(0)" : "=&v"(lo), "=&v"(hi) : "v"(a0), "v"(a1) : "memory");
    return (bf16x8){lo[0], lo[1], lo[2], lo[3], hi[0], hi[1], hi[2], hi[3]};
}
#define MFMA16(a, b, c) __builtin_amdgcn_mfma_f32_16x16x32_bf16((a), (b), (c), 0, 0, 0)

struct EpiH0 {
    static constexpr bool PERM = true, AFTER_DRAIN = false;
    bf16_t* H; float* ALR;
    __device__ __forceinline__ void operator()(const pg8::f32x4 (&acc)[2][2][4][2], const pg8::Unit& u, int wr, int wc, int fr, int fq) const {
        const int row0 = u.pm * 256 + wr * 64 + fr;
        if (u.pn == 12) {
            if (wc == 0 && fq < 2) {
#pragma unroll
                for (int ai = 0; ai < 2; ++ai)
#pragma unroll
                    for (int m = 0; m < 4; ++m) { float* rp = ALR + (size_t)(row0 + ai * 128 + m * 16) * 16 + 8 * fq;
                        *(f32x4*)rp = acc[ai][0][m][0]; *(f32x4*)(rp + 4) = acc[ai][0][m][1]; }
            }
            return;
        }
        const int act = (u.pn < 4) ? 0 : ((u.pn < 6 || u.pn >= 10) ? 1 : 2);
        const int col0 = u.pn * 256 + wc * 32 + 8 * fq;
#pragma unroll
        for (int ai = 0; ai < 2; ++ai)
#pragma unroll
            for (int m = 0; m < 4; ++m) { bf16_t* rowp = H + (size_t)(row0 + ai * 128 + m * 16) * LDH0 + col0;
#pragma unroll
                for (int bj = 0; bj < 2; ++bj) { f32x4 v0 = acc[ai][bj][m][0], v1 = acc[ai][bj][m][1];
                    if (act == 1) {
#pragma unroll
                        for (int j = 0; j < 4; ++j) { v0[j] = silu_f(v0[j]); v1[j] = silu_f(v1[j]); } }
                    else if (act == 2) {
#pragma unroll
                        for (int j = 0; j < 4; ++j) { v0[j] = gelu_f(v0[j]); v1[j] = gelu_f(v1[j]); } }
                    u32x4 w; w.x = pk2(v0[0], v0[1]); w.y = pk2(v0[2], v0[3]); w.z = pk2(v1[0], v1[1]); w.w = pk2(v1[2], v1[3]);
                    *(u32x4*)(rowp + bj * 128) = w; } }
    }
};
struct EpiH1 {
    static constexpr bool PERM = true, AFTER_DRAIN = false;
    bf16_t* H; const float* COS; const float* SIN;
    __device__ __forceinline__ void operator()(const pg8::f32x4 (&acc)[2][2][4][2], const pg8::Unit& u, int wr, int wc, int fr, int fq) const {
        const int row0 = u.pm * 256 + wr * 64 + fr;
        if (u.pn < 2) {
            const float sc = (u.pn == 0) ? 0.125f : 1.0f;
            const int d0 = 16 * (wc & 1) + 4 * fq;
#pragma unroll
            for (int ai = 0; ai < 2; ++ai)
#pragma unroll
                for (int m = 0; m < 4; ++m) { const int row = row0 + ai * 128 + m * 16;
                    const f32x4 cs = *(const f32x4*)(COS + (size_t)row * 32 + d0), sn = *(const f32x4*)(SIN + (size_t)row * 32 + d0);
#pragma unroll
                    for (int bj = 0; bj < 2; ++bj) { const int hh = 2 * bj + (wc >> 1);
                        const f32x4 x1 = acc[ai][bj][m][0] * sc, x2 = acc[ai][bj][m][1] * sc;
                        const f32x4 y1 = x1 * cs - x2 * sn, y2 = x1 * sn + x2 * cs;
                        bf16_t* p = H + (size_t)row * LDH1 + u.pn * 256 + 64 * hh + d0;
                        u32x2 a, b; a.x = pk2(y1[0], y1[1]); a.y = pk2(y1[2], y1[3]); b.x = pk2(y2[0], y2[1]); b.y = pk2(y2[2], y2[3]);
                        *(u32x2*)p = a; *(u32x2*)(p + 32) = b; } }
            return;
        }
        const bool act = (u.pn == 4 || u.pn == 5 || u.pn >= 8);
        const int col0 = u.pn * 256 + wc * 32 + 8 * fq;
#pragma unroll
        for (int ai = 0; ai < 2; ++ai)
#pragma unroll
            for (int m = 0; m < 4; ++m) { bf16_t* rowp = H + (size_t)(row0 + ai * 128 + m * 16) * LDH1 + col0;
#pragma unroll
                for (int bj = 0; bj < 2; ++bj) { f32x4 v0 = acc[ai][bj][m][0], v1 = acc[ai][bj][m][1];
                    if (act) {
#pragma unroll
                        for (int j = 0; j < 4; ++j) { v0[j] = silu_f(v0[j]); v1[j] = silu_f(v1[j]); } }
                    u32x4 w; w.x = pk2(v0[0], v0[1]); w.y = pk2(v0[2], v0[3]); w.z = pk2(v1[0], v1[1]); w.w = pk2(v1[2], v1[3]);
                    *(u32x4*)(rowp + bj * 128) = w; } }
    }
};

__device__ __forceinline__ int srcmap(int which, int c) {
    if (which == 0) { if (c < 1536) return c; if (c < 3072) return c + 16; if (c < 3088) return 1536 + (c - 3072); return -1; }
    if (which == 2) { if (c < 512) { const int s = c & 63; return (c & ~63) + 4 * (s >> 3) + (s & 3) + 32 * ((s >> 2) & 1); } return c; }
    return c;
}
__device__ __forceinline__ void transpose_item(const float* W, int Nsrc, bf16_t* WT, int which, int item, int ntn, float* scr, int tid) {
    const int kt = item / ntn, nt = item % ntn, k0 = kt * 64, n0 = nt * 64;
    { const int nn = tid & 63; const int src = srcmap(which, n0 + nn);
      for (int kk = tid >> 6; kk < 64; kk += 8) scr[kk * 65 + nn] = (src >= 0) ? W[(size_t)(k0 + kk) * Nsrc + src] : 0.f; }
    __syncthreads();
    { const int kk = tid & 63;
      for (int nn = tid >> 6; nn < 64; nn += 8) WT[(size_t)(n0 + nn) * 1024 + k0 + kk] = f2bf(scr[kk * 65 + nn]); }
    __syncthreads();
}
__device__ __forceinline__ void p0_prologue(const Params& p, unsigned char* smem, int tid) {
    unsigned char* ws = p.ws; float* scr = (float*)smem;
    constexpr int I0 = 16 * (N0PAD / 64), I1 = 16 * 16, I2 = 16 * (2560 / 64), I3 = 16 * 16;
    for (int it = blockIdx.x; it < I0 + I1 + I2 + I3; it += gridDim.x) {
        int r = it;
        if (r < I0) { transpose_item(p.in[2], 3088, (bf16_t*)(ws + WS_W0T), 0, r, N0PAD / 64, scr, tid); continue; } r -= I0;
        if (r < I1) { transpose_item(p.in[10], 1024, (bf16_t*)(ws + WS_WO0T), 1, r, 16, scr, tid); continue; } r -= I1;
        if (r < I2) { transpose_item(p.in[13], 2560, (bf16_t*)(ws + WS_W1T), 2, r, 40, scr, tid); continue; } r -= I2;
        transpose_item(p.in[17], 1024, (bf16_t*)(ws + WS_WO1T), 3, r, 16, scr, tid);
    }
    const int gtid = blockIdx.x * 512 + tid, nthr = gridDim.x * 512;
    { const float4* x4 = (const float4*)p.in[0]; u32x4* xb = (u32x4*)(ws + WS_XB);
      for (int i = gtid; i < MTOK * DM / 8; i += nthr) { const float4 a = x4[2 * i], b = x4[2 * i + 1];
          u32x4 w; w.x = pk2(a.x, a.y); w.y = pk2(a.z, a.w); w.z = pk2(b.x, b.y); w.w = pk2(b.z, b.w); xb[i] = w; } }
    { const int* pos = (const int*)p.in[1]; float* C = (float*)(ws + WS_COS); float* Sn = (float*)(ws + WS_SIN);
      for (int i = gtid; i < MTOK * 32; i += nthr) { const int tok = i >> 5, ii = i & 31;
          const float inv = powf(10000.0f, -(float)ii / 32.0f); const float ang = (float)pos[tok] * inv;
          C[i] = cosf(ang); Sn[i] = sinf(ang); } }
}

template <int C, int NH>
__device__ __forceinline__ void state_mma(unsigned KSa, unsigned VSa, float* UTblk  , int NCH, int pr0, int n, int w, int lane) {
    constexpr int WPH = 8 / NH, EPW = 128 / WPH, MT = EPW / 16, KST = C / 32, VSTR = (NH * 128 + 8) * 2;
    const int hh = w / WPH, eq = w % WPH, g = lane >> 4, l15 = lane & 15;
    bf16x8 Bf[4][KST];
#pragma unroll
    for (int nt = 0; nt < 4; ++nt)
#pragma unroll
        for (int ks = 0; ks < KST; ++ks) Bf[nt][ks] = lds_tr_frag(KSa + hh * (C * 144), 144, 32 * ks, 16 * nt, lane);
    float* UTp = UTblk + ((size_t)((pr0 + hh) * NCH + n) * 128 + EPW * eq) * 64 + (4 * g) * 64 + l15;
#pragma unroll
    for (int mt = 0; mt < MT; ++mt) {
        asm volatile("" ::: "memory");
        bf16x8 Af[KST];
#pragma unroll
        for (int ks = 0; ks < KST; ++ks) Af[ks] = lds_tr_frag(VSa, VSTR, 32 * ks, hh * 128 + EPW * eq + 16 * mt, lane);
#pragma unroll
        for (int nt = 0; nt < 4; ++nt) { f32x4 a = (f32x4){0.f, 0.f, 0.f, 0.f};
#pragma unroll
            for (int ks = 0; ks < KST; ++ks) a = MFMA16(Af[ks], Bf[nt][ks], a);
#pragma unroll
            for (int r = 0; r < 4; ++r) UTp[(16 * mt + r) * 64 + 16 * nt] = a[r]; }
    }
}

__device__ __forceinline__ void gla_prep_task(const Params& p, int task, unsigned char* smem, int tid) {
    unsigned char* ws = p.ws; bf16_t* H = (bf16_t*)(ws + WS_H);
    const int lane = tid & 63, w = tid >> 6;
    const int tok0 = task * 64, b = task >> 7, n = task & 127;
    float* ALRs = (float*)smem; float* TOT = (float*)(smem + 4096); unsigned char* KS = smem + 8192; unsigned char* VS = smem + 8192 + 36864;
    float* LA = (float*)VS;
    if (tid < 256) ((float4*)ALRs)[tid] = ((const float4*)((const float*)(ws + WS_ALR) + (size_t)tok0 * 16))[tid];
    __syncthreads();
    const int h = w >> 1, th = w & 1, d = lane;
    {
        float wa[16];
#pragma unroll
        for (int r = 0; r < 16; ++r) wa[r] = p.in[3][r * 256 + h * 64 + d];
        const float ba = p.in[4][h * 64 + d];
        float run = 0.f;
#pragma unroll 4
        for (int jj = 0; jj < 32; ++jj) { const int j = 32 * th + jj; float z = ba;
#pragma unroll
            for (int r = 0; r < 16; ++r) z = fmaf(ALRs[j * 16 + r], wa[r], z);
            const float la = (fminf(z, 0.f) - __logf(1.0f + __expf(-fabsf(z)))) * 0.0625f; run += la; LA[j * 256 + h * 64 + d] = run; }
        TOT[w * 64 + d] = run;
    }
    __syncthreads();
    {
        const float t0 = TOT[(2 * h) * 64 + d], t1 = TOT[(2 * h + 1) * 64 + d]; const float total = t0 + t1, off = th ? t0 : 0.f;
        bf16_t* Hq = H + (size_t)(tok0 + 32 * th) * LDH0 + h * 64 + d;
#pragma unroll 4
        for (int jj = 0; jj < 32; ++jj) { const float bj = LA[(32 * th + jj) * 256 + h * 64 + d] + off; bf16_t* pq = Hq + (size_t)jj * LDH0; const float qv = bf2f(pq[0]), kv = bf2f(pq[256]);
            pq[0] = f2bf(qv * 0.125f * __expf(bj)); pq[256] = f2bf(kv * __expf(-bj));
            *(bf16_t*)(KS + h * 9216 + (32 * th + jj) * 144 + d * 2) = f2bf(kv * __expf(total - bj)); }
        if (th == 0) ((float*)(ws + WS_DEC))[((size_t)(b * 4 + h) * 128 + n) * 64 + d] = __expf(total);
    }
    __syncthreads();
#pragma unroll
    for (int i = 0; i < 8; ++i) { const int id = tid + 512 * i, row = id >> 6, ch = id & 63;
        *(u32x4*)(VS + row * 1040 + ch * 16) = *(const u32x4*)(H + (size_t)(tok0 + row) * LDH0 + 512 + ch * 8); }
    __syncthreads();
    state_mma<64, 4>(lds_addr(KS), lds_addr(VS), (float*)(ws + WS_UT), 128, b * 4, n, w, lane);
    __syncthreads();
}

__device__ __forceinline__ void sgu_phase(const Params& p, unsigned char* smem, int tid) {
    unsigned char* ws = p.ws; const bf16_t* H = (const bf16_t*)(ws + WS_H); bf16_t* MIX = (bf16_t*)(ws + WS_MIX);
    const int lane = tid & 63, w = tid >> 6, g16 = lane >> 4, l15 = lane & 15;
    const int grp = blockIdx.x & 3;
    unsigned char* WM = smem; unsigned char* SVs = smem + 34816;
    for (int id = tid; id < 4096; id += 512) { const int row = id >> 5, c4 = id & 31;
        const float4 v = *(const float4*)(p.in[8] + (size_t)grp * 16384 + row * 128 + 4 * c4); const int s = 4 * c4;
        u32x2 o; o.x = pk2(s <= row ? v.x : 0.f, s + 1 <= row ? v.y : 0.f); o.y = pk2(s + 2 <= row ? v.z : 0.f, s + 3 <= row ? v.w : 0.f);
        *(u32x2*)(WM + row * 272 + c4 * 8) = o; }
    for (int task = blockIdx.x; task < 1024; task += gridDim.x) {
        const int bc = task >> 2, tok0 = bc * 128;
        { const int row = tid >> 2, q = tid & 3; const bf16_t* src = H + (size_t)(tok0 + row) * LDH0 + 2048 + grp * 128 + 32 * q;
          float v[32];
#pragma unroll
          for (int i = 0; i < 4; ++i) { const u32x4 t = *(const u32x4*)(src + 8 * i);
              v[8 * i + 0] = lo16(t.x); v[8 * i + 1] = hi16(t.x); v[8 * i + 2] = lo16(t.y); v[8 * i + 3] = hi16(t.y);
              v[8 * i + 4] = lo16(t.z); v[8 * i + 5] = hi16(t.z); v[8 * i + 6] = lo16(t.w); v[8 * i + 7] = hi16(t.w); }
          float s1 = 0.f;
#pragma unroll
          for (int i = 0; i < 32; ++i) s1 += v[i];
          s1 += __shfl_xor(s1, 1); s1 += __shfl_xor(s1, 2);
          const float mu = s1 * (1.0f / 128.0f); float s2 = 0.f;
#pragma unroll
          for (int i = 0; i < 32; ++i) { v[i] -= mu; s2 += v[i] * v[i]; }
          s2 += __shfl_xor(s2, 1); s2 += __shfl_xor(s2, 2);
          const float rstd = __builtin_amdgcn_rsqf(s2 * (1.0f / 128.0f) + LN_EPS);
          const float* lg = p.in[6] + grp * 128 + 32 * q; const float* lb = p.in[7] + grp * 128 + 32 * q;
#pragma unroll
          for (int i = 0; i < 4; ++i) { float o[8];
#pragma unroll
              for (int j = 0; j < 8; ++j) o[j] = v[8 * i + j] * rstd * lg[8 * i + j] + lb[8 * i + j];
              u32x4 t; t.x = pk2(o[0], o[1]); t.y = pk2(o[2], o[3]); t.z = pk2(o[4], o[5]); t.w = pk2(o[6], o[7]);
              *(u32x4*)(SVs + row * 272 + (32 * q + 8 * i) * 2) = t; } }
        __syncthreads();
        { f32x4 acc[8];
#pragma unroll
          for (int nt = 0; nt < 8; ++nt) acc[nt] = (f32x4){0.f, 0.f, 0.f, 0.f};
          const unsigned SVa = lds_addr(SVs);
#pragma unroll
          for (int ks = 0; ks < 4; ++ks) if (ks <= (w >> 1)) {
              const bf16x8 Af = *(const bf16x8*)(WM + (16 * w + l15) * 272 + (32 * ks + 8 * g16) * 2);
#pragma unroll
              for (int nt = 0; nt < 8; ++nt) { const bf16x8 Bf = lds_tr_frag(SVa, 272, 32 * ks, 16 * nt, lane); acc[nt] = MFMA16(Bf, Af, acc[nt]); } }
          const int t = 16 * w + l15, tok = tok0 + t; const float bs = p.in[9][grp * 128 + t];
          const bf16_t* hr = H + (size_t)tok * LDH0 + grp * 128; bf16_t* mr = MIX + (size_t)tok * 1024 + 512 + grp * 128;
#pragma unroll
          for (int nt = 0; nt < 8; ++nt) { const int c = 16 * nt + 4 * g16;
              const u32x2 uu = *(const u32x2*)(hr + 1536 + c), gb = *(const u32x2*)(hr + 2560 + c);
              u32x2 o; o.x = pk2(lo16(uu.x) * (acc[nt][0] + bs) * lo16(gb.x), hi16(uu.x) * (acc[nt][1] + bs) * hi16(gb.x));
              o.y = pk2(lo16(uu.y) * (acc[nt][2] + bs) * lo16(gb.y), hi16(uu.y) * (acc[nt][3] + bs) * hi16(gb.y));
              *(u32x2*)(mr + c) = o; } }
        __syncthreads();
    }
}

template <int NCH, bool RET>
__device__ __forceinline__ void scan_phase(const Params& p, int tid) {
    unsigned char* ws = p.ws; const float* UT = (const float*)(ws + WS_UT); const float* DEC = (const float*)(ws + WS_DEC); bf16_t* ST = (bf16_t*)(ws + WS_ST);
    for (int e = blockIdx.x * 512 + tid; e < 16 * 8192; e += gridDim.x * 512) {
        const int pr = e >> 13, rem = e & 8191, d = rem & 63;
        const float decc = RET ? __expf(128.0f * __logf(1.0f - exp2f(-5.0f - (float)(pr & 3)))) : 0.f;
        const float* up = UT + (size_t)pr * NCH * 8192 + rem; const float* dp = DEC + (size_t)pr * NCH * 64 + d; bf16_t* sp = ST + (size_t)pr * NCH * 8192 + rem;
        float s = 0.f;
        for (int n0 = 0; n0 < NCH; n0 += 8) { float u[8], dc[8];
#pragma unroll
            for (int i = 0; i < 8; ++i) { u[i] = up[(size_t)(n0 + i) * 8192]; dc[i] = RET ? decc : dp[(n0 + i) * 64]; }
#pragma unroll
            for (int i = 0; i < 8; ++i) { sp[(size_t)(n0 + i) * 8192] = f2bf(s); s = dc[i] * s + u[i]; } }
    }
}

template <int C, int NH, bool RET, int LDH>
__device__ __forceinline__ void chunk_out_task(const Params& p, int task, unsigned char* smem, int tid, const float* normg) {
    constexpr int WPH = 8 / NH, NHP = 4 / NH, NCH = SEQ / C, VSTR = (NH * 128 + 8) * 2, PSTR = (C + 8) * 2, VBYTES = C * VSTR, NJT = C / 16, CPR = NH * 16;
    unsigned char* ws = p.ws; const bf16_t* H = (const bf16_t*)(ws + WS_H); bf16_t* MIX = (bf16_t*)(ws + WS_MIX);
    const int lane = tid & 63, w = tid >> 6, g = lane >> 4, l15 = lane & 15;
    const int hp = task % NHP, bc = task / NHP, tok0 = bc * C, b = bc / NCH, n = bc % NCH;
    unsigned char* VS = smem; unsigned char* Pw = smem + VBYTES + w * (32 * PSTR);
    for (int id = tid; id < C * CPR; id += 512) { const int row = id / CPR, ch = id % CPR;
        *(u32x4*)(VS + row * VSTR + ch * 16) = *(const u32x4*)(H + (size_t)(tok0 + row) * LDH + 512 + hp * NH * 128 + ch * 8); }
    const int hh = w / WPH, rq = w % WPH, h = hp * NH + hh, pr = b * 4 + h, i0 = 32 * rq;
    const float lg2 = RET ? log2f(1.0f - exp2f(-5.0f - (float)h)) : 0.f;
    bf16x8 Qf[2][2];
#pragma unroll
    for (int mi = 0; mi < 2; ++mi)
#pragma unroll
        for (int ks = 0; ks < 2; ++ks) Qf[mi][ks] = *(const bf16x8*)(H + (size_t)(tok0 + i0 + 16 * mi + l15) * LDH + h * 64 + 32 * ks + 8 * g);
#pragma unroll
    for (int nj = 0; nj < NJT; ++nj) if (nj <= 2 * rq + 1) {
        const bf16_t* kp = H + (size_t)(tok0 + 16 * nj + l15) * LDH + 256 + h * 64 + 8 * g;
        const bf16x8 K0 = *(const bf16x8*)kp, K1 = *(const bf16x8*)(kp + 32);
#pragma unroll
        for (int mi = 0; mi < 2; ++mi) { f32x4 s = (f32x4){0.f, 0.f, 0.f, 0.f}; s = MFMA16(Qf[mi][0], K0, s); s = MFMA16(Qf[mi][1], K1, s);
#pragma unroll
            for (int r = 0; r < 4; ++r) { const int il = 16 * mi + 4 * g + r, i = i0 + il, j = 16 * nj + l15; float v = s[r];
                if (RET) v *= exp2f((float)(i - j) * lg2);
                if (j > i) v = 0.f;
                *(bf16_t*)(Pw + il * PSTR + j * 2) = f2bf(v); } }
        asm volatile("" ::: "memory");
    }
    __syncthreads();
    f32x4 acc[2][8];
#pragma unroll
    for (int mi = 0; mi < 2; ++mi)
#pragma unroll
        for (int nt = 0; nt < 8; ++nt) acc[mi][nt] = (f32x4){0.f, 0.f, 0.f, 0.f};
    { const bf16_t* STp = (const bf16_t*)(ws + WS_ST) + ((size_t)(pr * NCH + n) * 128) * 64;
#pragma unroll
      for (int nt = 0; nt < 8; ++nt) { const bf16_t* sp = STp + (16 * nt + l15) * 64 + 8 * g; const bf16x8 B0 = *(const bf16x8*)sp, B1 = *(const bf16x8*)(sp + 32);
#pragma unroll
          for (int mi = 0; mi < 2; ++mi) { acc[mi][nt] = MFMA16(B0, Qf[mi][0], acc[mi][nt]); acc[mi][nt] = MFMA16(B1, Qf[mi][1], acc[mi][nt]); }
          if (nt & 1) asm volatile("" ::: "memory"); } }
    if (RET) {
#pragma unroll
        for (int mi = 0; mi < 2; ++mi) { const float f = exp2f((float)(i0 + 16 * mi + l15 + 1) * lg2);
#pragma unroll
            for (int nt = 0; nt < 8; ++nt) acc[mi][nt] *= f; } }
    { const unsigned VSa = lds_addr(VS);
#pragma unroll
      for (int ks2 = 0; ks2 < WPH; ++ks2) if (ks2 <= rq) {
          bf16x8 Pf[2];
#pragma unroll
          for (int mi = 0; mi < 2; ++mi) Pf[mi] = *(const bf16x8*)(Pw + (16 * mi + l15) * PSTR + (32 * ks2 + 8 * g) * 2);
#pragma unroll
          for (int nt = 0; nt < 8; ++nt) { const bf16x8 Vf = lds_tr_frag(VSa, VSTR, 32 * ks2, hh * 128 + 16 * nt, lane);
#pragma unroll
              for (int mi = 0; mi < 2; ++mi) acc[mi][nt] = MFMA16(Vf, Pf[mi], acc[mi][nt]); } } }
#pragma unroll
    for (int mi = 0; mi < 2; ++mi) {
        float mu = 0.f;
        if (RET) { float s1 = 0.f;
#pragma unroll
            for (int nt = 0; nt < 8; ++nt) s1 += (acc[mi][nt][0] + acc[mi][nt][1]) + (acc[mi][nt][2] + acc[mi][nt][3]);
            s1 += __shfl_xor(s1, 16); s1 += __shfl_xor(s1, 32); mu = s1 * (1.0f / 128.0f); }
        float s2 = 0.f;
#pragma unroll
        for (int nt = 0; nt < 8; ++nt) { const f32x4 dlt = acc[mi][nt] - mu; s2 += (dlt[0] * dlt[0] + dlt[1] * dlt[1]) + (dlt[2] * dlt[2] + dlt[3] * dlt[3]); }
        s2 += __shfl_xor(s2, 16); s2 += __shfl_xor(s2, 32);
        const float rstd = __builtin_amdgcn_rsqf(s2 * (1.0f / 128.0f) + LN_EPS);
        const int tok = tok0 + i0 + 16 * mi + l15;
        const bf16_t* gp = H + (size_t)tok * LDH + 1024 + h * 128 + 4 * g; bf16_t* mp = MIX + (size_t)tok * 1024 + h * 128 + 4 * g; const float* ng = normg + h * 128 + 4 * g;
#pragma unroll
        for (int nt = 0; nt < 8; ++nt) { const u32x2 gt = *(const u32x2*)(gp + 16 * nt); const f32x4 gn = *(const f32x4*)(ng + 16 * nt); const f32x4 v = (acc[mi][nt] - mu) * rstd * gn;
            u32x2 o; o.x = pk2(v[0] * lo16(gt.x), v[1] * hi16(gt.x)); o.y = pk2(v[2] * lo16(gt.y), v[3] * hi16(gt.y));
            *(u32x2*)(mp + 16 * nt) = o; }
    }
    __syncthreads();
}

__device__ __forceinline__ void ret_state_task(const Params& p, int task, unsigned char* smem, int tid) {
    unsigned char* ws = p.ws; const bf16_t* H = (const bf16_t*)(ws + WS_H);
    const int lane = tid & 63, w = tid >> 6;
    const int hp = task & 1, bc = task >> 1, tok0 = bc * 128, b = bc >> 6, n = bc & 63;
    unsigned char* KS = smem; unsigned char* VS = smem + 36864;
#pragma unroll
    for (int i = 0; i < 4; ++i) { const int id = tid + 512 * i, row = id >> 4, ch = id & 15, hh = ch >> 3;
        const u32x4 t = *(const u32x4*)(H + (size_t)(tok0 + row) * LDH1 + 256 + hp * 128 + ch * 8);
        const float lg2 = log2f(1.0f - exp2f(-5.0f - (float)(hp * 2 + hh))); const float f = exp2f((float)(127 - row) * lg2);
        u32x4 o; o.x = pk2(lo16(t.x) * f, hi16(t.x) * f); o.y = pk2(lo16(t.y) * f, hi16(t.y) * f); o.z = pk2(lo16(t.z) * f, hi16(t.z) * f); o.w = pk2(lo16(t.w) * f, hi16(t.w) * f);
        *(u32x4*)(KS + hh * 18432 + row * 144 + (ch & 7) * 16) = o; }
#pragma unroll
    for (int i = 0; i < 8; ++i) { const int id = tid + 512 * i, row = id >> 5, ch = id & 31;
        *(u32x4*)(VS + row * 528 + ch * 16) = *(const u32x4*)(H + (size_t)(tok0 + row) * LDH1 + 512 + hp * 256 + ch * 8); }
    __syncthreads();
    state_mma<128, 2>(lds_addr(KS), lds_addr(VS), (float*)(ws + WS_UT), 64, b * 4 + hp * 2, n, w, lane);
    __syncthreads();
}

__device__ __forceinline__ void pool_phase(const Params& p, unsigned char* smem, int tid) {
    unsigned char* ws = p.ws; const bf16_t* H = (const bf16_t*)(ws + WS_H); bf16_t* MIX = (bf16_t*)(ws + WS_MIX);
    const int lane = tid & 63, w = tid >> 6, g16 = lane >> 4, l15 = lane & 15;
    const int grp = blockIdx.x & 3, win = 2 << grp;
    unsigned char* WP = smem; unsigned char* PT = smem + 34816; unsigned char* PL = smem + 34816 + 39168;
    for (int id = tid; id < 4096; id += 512) { const int row = id >> 5, c4 = id & 31;
        const float4 v = *(const float4*)(p.in[15] + (size_t)grp * 16384 + row * 128 + 4 * c4);
        u32x2 o; o.x = pk2(v.x, v.y); o.y = pk2(v.z, v.w); *(u32x2*)(WP + row * 272 + c4 * 8) = o; }
    for (int task = blockIdx.x; task < 1024; task += gridDim.x) {
        const int bc = task >> 2, tok0 = bc * 128, s0 = tok0 & (SEQ - 1);
        for (int id = tid; id < 144 * 16; id += 512) { const int row = id >> 4, ch = id & 15;
            u32x4 t = (u32x4){0u, 0u, 0u, 0u};
            if (!(row < 16 && s0 == 0)) t = *(const u32x4*)(H + (size_t)(tok0 - 16 + row) * LDH1 + 1536 + grp * 128 + ch * 8);
            *(u32x4*)(PT + row * 272 + ch * 16) = t; }
        __syncthreads();
        { const int c = tid & 127, tq = tid >> 7, ts = 32 * tq; const bf16_t* col = (const bf16_t*)PT + c;
          float sum = 0.f;
          for (int i = 1; i < win; ++i) sum += bf2f(col[(16 + ts - i) * 136]);
          for (int tt = 0; tt < 32; ++tt) { const int tl = ts + tt; const float cur = bf2f(col[(16 + tl) * 136]); sum += cur;
              const int cnt = min(s0 + tl + 1, win); const float pooled = sum / (float)cnt - cur;
              *((bf16_t*)PL + tl * 136 + c) = f2bf(pooled);
              sum -= bf2f(col[(16 + tl - win + 1) * 136]); } }
        __syncthreads();
        { f32x4 acc[8];
#pragma unroll
          for (int nt = 0; nt < 8; ++nt) acc[nt] = (f32x4){0.f, 0.f, 0.f, 0.f};
          const unsigned WPa = lds_addr(WP);
#pragma unroll
          for (int ks = 0; ks < 4; ++ks) {
              const bf16x8 Af = *(const bf16x8*)(PL + (16 * w + l15) * 272 + (32 * ks + 8 * g16) * 2);
#pragma unroll
              for (int nt = 0; nt < 8; ++nt) { const bf16x8 Bf = lds_tr_frag(WPa, 272, 32 * ks, 16 * nt, lane); acc[nt] = MFMA16(Bf, Af, acc[nt]); } }
          const int t = 16 * w + l15, tok = tok0 + t;
          const bf16_t* hr = H + (size_t)tok * LDH1 + 2048 + grp * 128; bf16_t* mr = MIX + (size_t)tok * 1024 + 512 + grp * 128; const float* sc = p.in[16] + grp * 128;
#pragma unroll
          for (int nt = 0; nt < 8; ++nt) { const int c = 16 * nt + 4 * g16; const u32x2 gd = *(const u32x2*)(hr + c); const f32x4 s4 = *(const f32x4*)(sc + c);
              u32x2 o; o.x = pk2(acc[nt][0] * s4[0] * lo16(gd.x), acc[nt][1] * s4[1] * hi16(gd.x)); o.y = pk2(acc[nt][2] * s4[2] * lo16(gd.y), acc[nt][3] * s4[3] * hi16(gd.y));
              *(u32x2*)(mr + c) = o; } }
        __syncthreads();
    }
}

template <bool WRITE_BF>
__device__ __forceinline__ void ln_phase(const float* xin, const float* Y, const float* gam, const float* bet, float* out, bf16_t* XB, int tid) {
    const int lane = tid & 63, gw = blockIdx.x * 8 + (tid >> 6), nw = gridDim.x * 8;
    f32x4 gv[4], bv[4];
#pragma unroll
    for (int j = 0; j < 4; ++j) { gv[j] = ((const f32x4*)gam)[lane + 64 * j]; bv[j] = ((const f32x4*)bet)[lane + 64 * j]; }
    for (int row = gw; row < MTOK; row += nw) {
        const f32x4* xr = (const f32x4*)(xin + (size_t)row * DM); const f32x4* yr = (const f32x4*)(Y + (size_t)row * DM);
        f32x4 v[4]; float s1 = 0.f;
#pragma unroll
        for (int j = 0; j < 4; ++j) { v[j] = xr[lane + 64 * j] * DN_ALPHA + yr[lane + 64 * j]; s1 += (v[j][0] + v[j][1]) + (v[j][2] + v[j][3]); }
        const float mu = wave_sum(s1) * (1.0f / DM); float s2 = 0.f;
#pragma unroll
        for (int j = 0; j < 4; ++j) { v[j] = v[j] - mu; s2 += (v[j][0] * v[j][0] + v[j][1] * v[j][1]) + (v[j][2] * v[j][2] + v[j][3] * v[j][3]); }
        const float rstd = 1.0f / sqrtf(wave_sum(s2) * (1.0f / DM) + LN_EPS);
#pragma unroll
        for (int j = 0; j < 4; ++j) { const f32x4 o = v[j] * rstd * gv[j] + bv[j];
            ((f32x4*)(out + (size_t)row * DM))[lane + 64 * j] = o;
            if (WRITE_BF) { u32x2 t; t.x = pk2(o[0], o[1]); t.y = pk2(o[2], o[3]); ((u32x2*)(XB + (size_t)row * DM))[lane + 64 * j] = t; } }
    }
}


constexpr int PTAB_OFF = LDS_BYTES - 256;
__device__ __forceinline__ unsigned long long lds_u64_uniform(const unsigned char* smem, int i) {
    const unsigned long long v = *(const volatile PG8_LAS unsigned long long*)((const PG8_LAS unsigned char*)smem + PTAB_OFF + 8 * i);
    const unsigned lo = __builtin_amdgcn_readfirstlane((unsigned)v), hi = __builtin_amdgcn_readfirstlane((unsigned)(v >> 32));
    return ((unsigned long long)hi << 32) | lo;
}
__device__ __forceinline__ Params load_params(const unsigned char* smem, unsigned long long need) {
    Params q;
#pragma unroll
    for (int i = 0; i < 20; ++i) q.in[i] = ((need >> i) & 1ull) ? (const float*)lds_u64_uniform(smem, i) : nullptr;
    q.out = ((need >> 20) & 1ull) ? (float*)lds_u64_uniform(smem, 20) : nullptr;
    q.ws = (unsigned char*)lds_u64_uniform(smem, 21);
    return q;
}

__global__ void __launch_bounds__(512, 2) mega_fwd(Params p) {
    extern __shared__ __attribute__((aligned(16))) unsigned char smem[];
    cg::grid_group grid = cg::this_grid();
    const int wv = __builtin_amdgcn_readfirstlane(threadIdx.x >> 6);
    int tid;
    PG8_LAS unsigned char* lds3 = (PG8_LAS unsigned char*)smem;
    if (threadIdx.x == 0) {
        unsigned long long* tab = (unsigned long long*)(smem + PTAB_OFF);
#pragma unroll
        for (int i = 0; i < 20; ++i) tab[i] = (unsigned long long)p.in[i];
        tab[20] = (unsigned long long)p.out; tab[21] = (unsigned long long)p.ws;
    }
    __syncthreads();
#ifndef PM
#define PM 0xFFFF
#endif
#define BIT(i) (1ull << (i))
#define PH(k, need) asm volatile("v_mbcnt_lo_u32_b32 %0, -1, 0\n\tv_mbcnt_hi_u32_b32 %0, -1, %0" : "=v"(tid)); tid += wv * 64; if ((PM >> (k)) & 1) { const Params q = load_params(smem, need); unsigned char* ws = q.ws; (void)ws;
#define WSP(T, off) ((T*)(ws + (off)))
    PH(0, BIT(0) | BIT(1) | BIT(2) | BIT(10) | BIT(13) | BIT(17)) p0_prologue(q, smem, tid); }
    grid.sync();
    PH(1, 0) pg8::Gemm g{WSP(bf16_t, WS_XB), WSP(const bf16_t, WS_W0T), MTOK, N0PAD, DM}; pg8::StaticOrder So; So.init(MTOK, N0PAD, (int)gridDim.x, (int)blockIdx.x);
      EpiH0 E{WSP(bf16_t, WS_H), WSP(float, WS_ALR)}; pg8::gemm_phase<EpiH0, pg8::StaticOrder, false>(lds3, g, So, E, nullptr, tid); }
    grid.sync();
    PH(2, BIT(3) | BIT(4)) for (int task = blockIdx.x; task < 512; task += gridDim.x) gla_prep_task(q, task, smem, tid); }
    __syncthreads();
    PH(3, BIT(6) | BIT(7) | BIT(8) | BIT(9)) sgu_phase(q, smem, tid); }
    grid.sync();
    PH(4, 0) scan_phase<128, false>(q, tid); }
    grid.sync();
    PH(5, BIT(5)) for (int task = blockIdx.x; task < 512; task += gridDim.x) chunk_out_task<64, 4, false, LDH0>(q, task, smem, tid, q.in[5]); }
    grid.sync();
    PH(6, 0) pg8::Gemm g{WSP(bf16_t, WS_MIX), WSP(const bf16_t, WS_WO0T), MTOK, DM, DM}; pg8::StaticOrder So; So.init(MTOK, DM, (int)gridDim.x, (int)blockIdx.x);
      pg8::EpiF32 E{WSP(float, WS_H), DM, nullptr}; pg8::gemm_phase<pg8::EpiF32, pg8::StaticOrder, false>(lds3, g, So, E, nullptr, tid); }
    grid.sync();
    PH(7, BIT(0) | BIT(11) | BIT(12) | BIT(20)) ln_phase<true>(q.in[0], WSP(float, WS_H), q.in[11], q.in[12], q.out, WSP(bf16_t, WS_XB), tid); }
    grid.sync();
    PH(8, 0) pg8::Gemm g{WSP(bf16_t, WS_XB), WSP(const bf16_t, WS_W1T), MTOK, 2560, DM}; pg8::StaticOrder So; So.init(MTOK, 2560, (int)gridDim.x, (int)blockIdx.x);
      EpiH1 E{WSP(bf16_t, WS_H), WSP(const float, WS_COS), WSP(const float, WS_SIN)}; pg8::gemm_phase<EpiH1, pg8::StaticOrder, false>(lds3, g, So, E, nullptr, tid); }
    grid.sync();
    PH(9, 0) for (int task = blockIdx.x; task < 512; task += gridDim.x) ret_state_task(q, task, smem, tid); }
    __syncthreads();
    PH(10, BIT(15) | BIT(16)) pool_phase(q, smem, tid); }
    grid.sync();
    PH(11, 0) scan_phase<64, true>(q, tid); }
    grid.sync();
    PH(12, BIT(14)) for (int task = blockIdx.x; task < 512; task += gridDim.x) chunk_out_task<128, 2, true, LDH1>(q, task, smem, tid, q.in[14]); }
    grid.sync();
    PH(13, 0) pg8::Gemm g{WSP(bf16_t, WS_MIX), WSP(const bf16_t, WS_WO1T), MTOK, DM, DM}; pg8::StaticOrder So; So.init(MTOK, DM, (int)gridDim.x, (int)blockIdx.x);
      pg8::EpiF32 E{WSP(float, WS_H), DM, nullptr}; pg8::gemm_phase<pg8::EpiF32, pg8::StaticOrder, false>(lds3, g, So, E, nullptr, tid); }
    grid.sync();
    PH(14, BIT(18) | BIT(19) | BIT(20)) ln_phase<false>(q.out, WSP(float, WS_H), q.in[18], q.in[19], q.out, nullptr, tid); }
}

extern "C" void kernel_launch(void* const* d_in, const int* in_sizes, int n_in, void* d_out, int out_size, void* d_ws, size_t ws_size, hipStream_t stream) {
    static int grid_blocks = 0;
    if (grid_blocks == 0) {
        if (n_in != 20 || ws_size < WS_END) { fprintf(stderr, "kernel_launch: unexpected n_in %d or ws_size %zu (need %zu)\n", n_in, ws_size, (size_t)WS_END); grid_blocks = -1; return; }
        int dev = 0, cus = 0, per_cu = 0;
        hipGetDevice(&dev);
        hipDeviceGetAttribute(&cus, hipDeviceAttributeMultiprocessorCount, dev);
        if (hipFuncSetAttribute((const void*)mega_fwd, hipFuncAttributeMaxDynamicSharedMemorySize, LDS_BYTES) != hipSuccess) { fprintf(stderr, "kernel_launch: hipFuncSetAttribute failed\n"); grid_blocks = -1; return; }
        if (hipOccupancyMaxActiveBlocksPerMultiprocessor(&per_cu, (const void*)mega_fwd, 512, LDS_BYTES) != hipSuccess || per_cu < 1) { fprintf(stderr, "kernel_launch: occupancy query gave %d\n", per_cu); grid_blocks = -1; return; }
        grid_blocks = cus;
        grid_blocks &= ~7;
        if (grid_blocks < 8) { grid_blocks = -1; return; }
    }
    if (grid_blocks < 0) return;
    Params p{};
    for (int i = 0; i < 20; ++i) p.in[i] = (const float*)d_in[i];
    p.out = (float*)d_out; p.ws = (unsigned char*)d_ws;
    void* args[] = {&p};
    hipError_t e = hipLaunchCooperativeKernel((const void*)mega_fwd, dim3(grid_blocks), dim3(512), args, LDS_BYTES, stream);
    if (e != hipSuccess) fprintf(stderr, "cooperative launch failed: %s (grid %d)\n", hipGetErrorString(e), grid_blocks);
}
```

```cpp
#include <hip/hip_runtime.h>
#include <hip/hip_cooperative_groups.h>
#include <cstdio>
namespace pg8 {
#define PG8_LAS __attribute__((address_space(3)))
typedef unsigned short bf16_t;
typedef short bf16x8 __attribute__((ext_vector_type(8)));
typedef float f32x4 __attribute__((ext_vector_type(4)));
typedef unsigned u32x4 __attribute__((ext_vector_type(4)));
constexpr int BM = 256, BK = 64, HALF = 128, HTB = HALF * BK * 2  , STAGE_BYTES = 8 * HTB, NXCD = 8, WGM = 8;

__host__ __device__ __forceinline__ int lds_byte(int r, int c) { const int st = (r >> 4) * 2 + (c >> 5), rr = r & 15, cc = c & 31, ob = rr * 64 + cc * 2; return st * 1024 + (ob ^ (((ob >> 9) & 1) << 5)); }
__host__ __device__ __forceinline__ void stage_rc(int b, int& R, int& C) { const int st = b / 1024, sb = b % 1024, swz = sb ^ (((sb >> 9) & 1) << 5); R = (st >> 1) * 16 + swz / 64; C = (st & 1) * 32 + (swz % 64) / 2; }
__host__ __device__ __forceinline__ int perm32(int rho) { const int n = rho >> 4, i = rho & 15; return 8 * (i >> 2) + 4 * n + (i & 3); }

struct Unit { int pm, pn; };
struct Gemm { const bf16_t* A; const bf16_t* Bt; int M, N, K; };

struct StaticOrder {
    int nM, nN, nwg, G, c;
    __host__ __device__ void init(int M, int N, int G_, int c_) { nM = M / BM; nN = N / BM; nwg = nM * nN; G = G_; c = c_; }
    __host__ __device__ bool next(int i, Unit& u) const {
        const long L = (long)i * G + c; if (L >= nwg) return false;
        int wgid = (int)L; { const int q = nwg / NXCD, r = nwg % NXCD, xcd = wgid % NXCD, off = wgid / NXCD; wgid = (xcd < r ? xcd * (q + 1) : r * (q + 1) + (xcd - r) * q) + off; }
        const int nig = WGM * nN, gid = wgid / nig, fm = gid * WGM, gsz = (nM - fm) < WGM ? (nM - fm) : WGM;
        u.pm = fm + ((wgid % nig) % gsz); u.pn = (wgid % nig) / gsz; return true;
    }
    __device__ __forceinline__ void a_ready(const Unit&) const {}
    __device__ __forceinline__ void done(const Unit&) const {}
};
struct CountedOrder : StaticOrder {
    const unsigned* ready; unsigned need; unsigned* tmo;
    __device__ __forceinline__ void a_ready(const Unit& u) const {
        if (threadIdx.x < 64) {
            const unsigned long long t0 = __builtin_amdgcn_s_memrealtime(); unsigned polls = 0;
            while ((unsigned)__builtin_amdgcn_readfirstlane(__hip_atomic_load(ready + 64 * u.pm, __ATOMIC_RELAXED, __HIP_MEMORY_SCOPE_AGENT)) < need) {
                if ((++polls & 255u) == 0u && __builtin_amdgcn_readfirstlane(__hip_atomic_load(tmo, __ATOMIC_RELAXED, __HIP_MEMORY_SCOPE_AGENT)) != 0u) break;
                if (__builtin_amdgcn_s_memrealtime() - t0 > 2000000ull) {
                    if (threadIdx.x == 0) { unsigned expect = 0u; __hip_atomic_compare_exchange_strong(tmo + 1, &expect, 0x600u | (unsigned)(u.pm & 0xff), __ATOMIC_RELAXED, __ATOMIC_RELAXED, __HIP_MEMORY_SCOPE_AGENT); __hip_atomic_store(tmo, 1u, __ATOMIC_RELAXED, __HIP_MEMORY_SCOPE_AGENT); }
                    break; }
                __builtin_amdgcn_s_sleep(2); }
            __builtin_amdgcn_fence(__ATOMIC_ACQUIRE, "agent");
            asm volatile("s_waitcnt vmcnt(0)" ::: "memory");
        }
#if !defined(BROKEN_HOOK_NO_BARRIER)
        asm volatile("" ::: "memory"); __builtin_amdgcn_s_barrier(); asm volatile("" ::: "memory");
#endif
    }
};

__device__ __forceinline__ unsigned cvt_pk_bf16(float lo, float hi) { unsigned r; asm volatile("v_cvt_pk_bf16_f32 %0, %1, %2" : "=v"(r) : "v"(lo), "v"(hi)); return r; }
typedef float f32x2 __attribute__((ext_vector_type(2)));
__device__ __forceinline__ f32x2 gelu_pk(f32x2 v) {
    const f32x2 av = __builtin_elementwise_abs(v), d = av * 0.2316418882f + 1.0f;
    f32x2 t; t.x = __builtin_amdgcn_rcpf(d.x); t.y = __builtin_amdgcn_rcpf(d.y);
    f32x2 q = t * 0.5307027145f + (-0.7265760135f); q = q * t + 0.7107068705f; q = q * t + (-0.142248368f); q = q * t + 0.127414796f; q = q * t;
    const f32x2 s = (v * v) * (-0.72134752044f);
    f32x2 e; e.x = __builtin_amdgcn_exp2f(s.x); e.y = __builtin_amdgcn_exp2f(s.y);
    const f32x2 m = v * (q * e), r = v - m;
    f32x2 o; o.x = v.x < 0.f ? m.x : r.x; o.y = v.y < 0.f ? m.y : r.y; return o;
}

struct EpiF32 {
    static constexpr bool PERM = false, AFTER_DRAIN = false;
    float* C; int ldc; const float* bias;
    __device__ __forceinline__ void operator()(const f32x4 (&acc)[2][2][4][2], const Unit& u, int wr, int wc, int fr, int fq) const {
        const int row0 = u.pm * BM + wr * 64 + fr, col0 = u.pn * BM + wc * 32 + 4 * fq;
        f32x4 bv[2][2];
#pragma unroll
        for (int bj = 0; bj < 2; ++bj)
#pragma unroll
            for (int n = 0; n < 2; ++n) bv[bj][n] = bias ? *(const f32x4*)(bias + col0 + bj * HALF + n * 16) : (f32x4){0.f, 0.f, 0.f, 0.f};
#pragma unroll
        for (int ai = 0; ai < 2; ++ai)
#pragma unroll
            for (int m = 0; m < 4; ++m) { float* rowp = C + (size_t)(row0 + ai * HALF + m * 16) * ldc + col0;
#pragma unroll
                for (int bj = 0; bj < 2; ++bj)
#pragma unroll
                    for (int n = 0; n < 2; ++n) *(f32x4*)(rowp + bj * HALF + n * 16) = acc[ai][bj][m][n] + bv[bj][n]; }
    }
};
template <int ACT  > struct EpiBf16 {
    static constexpr bool PERM = true, AFTER_DRAIN = false;
    bf16_t* O; int ldc; const float* bias; int split_cols; size_t split_stride;
    __device__ __forceinline__ void operator()(const f32x4 (&acc)[2][2][4][2], const Unit& u, int wr, int wc, int fr, int fq) const {
        const int row0 = u.pm * BM + wr * 64 + fr; int colt = u.pn * BM; bf16_t* base = O;
        if (split_cols) { const int t = colt / split_cols; base += (size_t)t * split_stride; colt -= t * split_cols; }
        const int col0 = colt + wc * 32 + 8 * fq, bcol0 = u.pn * BM + wc * 32 + 8 * fq;
        f32x4 bv[2][2];
#pragma unroll
        for (int bj = 0; bj < 2; ++bj)
#pragma unroll
            for (int n = 0; n < 2; ++n) bv[bj][n] = bias ? *(const f32x4*)(bias + bcol0 + bj * HALF + 4 * n) : (f32x4){0.f, 0.f, 0.f, 0.f};
#pragma unroll
        for (int ai = 0; ai < 2; ++ai)
#pragma unroll
            for (int m = 0; m < 4; ++m) { bf16_t* rowp = base + (size_t)(row0 + ai * HALF + m * 16) * ldc + col0;
#pragma unroll
                for (int bj = 0; bj < 2; ++bj) { f32x4 v0 = acc[ai][bj][m][0] + bv[bj][0], v1 = acc[ai][bj][m][1] + bv[bj][1];
                    if (ACT == 1) { f32x2 a = gelu_pk((f32x2){v0[0], v0[1]}), b = gelu_pk((f32x2){v0[2], v0[3]}), c = gelu_pk((f32x2){v1[0], v1[1]}), d = gelu_pk((f32x2){v1[2], v1[3]});
                        v0 = (f32x4){a.x, a.y, b.x, b.y}; v1 = (f32x4){c.x, c.y, d.x, d.y}; }
                    if (ACT == 2) {
#pragma unroll
                        for (int j = 0; j < 4; ++j) { v0[j] = 0.5f * v0[j] * (1.0f + erff(v0[j] * 0.70710678f)); v1[j] = 0.5f * v1[j] * (1.0f + erff(v1[j] * 0.70710678f)); } }
                    u32x4 w; w.x = cvt_pk_bf16(v0[0], v0[1]); w.y = cvt_pk_bf16(v0[2], v0[3]); w.z = cvt_pk_bf16(v1[0], v1[1]); w.w = cvt_pk_bf16(v1[2], v1[3]);
                    *(u32x4*)(rowp + bj * HALF) = w; } }
    }
};

template <class Epi, class Sched, bool STAMP = false>
__device__ __forceinline__ void gemm_phase(PG8_LAS unsigned char* lds, const Gemm g, const Sched& S, const Epi& E, unsigned long long* stamps, int tid_in) {
    int tid_ = tid_in; asm volatile("" : "+v"(tid_)); const int tid = tid_, wid = __builtin_amdgcn_readfirstlane(tid >> 6), lane = tid & 63, wr = wid >> 2, wc = wid & 3, fr = lane & 15, fq = lane >> 4;
    const int K = g.K, nt = K / BK;
    int ts_lo = 0, ts_hi = 0, nts = 0; const unsigned long long rt_entry = STAMP ? (unsigned long long)wall_clock64() : 0ull;
#define PG8_STAMP() do { if (STAMP && wid == 0 && nts < 64) { const unsigned long long _c = (unsigned long long)clock64(); \
        ts_lo = (lane == nts) ? (int)(unsigned)_c : ts_lo; ts_hi = (lane == nts) ? (int)(unsigned)(_c >> 32) : ts_hi; ++nts; } } while (0)
    PG8_STAMP();
    unsigned voffA[2], voffB[2];
#pragma unroll
    for (int i = 0; i < 2; ++i) { int R, C; stage_rc(tid * 16 + i * 8192, R, C); const int Rb = Epi::PERM ? ((R & ~31) + perm32(R & 31)) : R;
        voffA[i] = (unsigned)(R * K + C) * 2u; voffB[i] = (unsigned)(Rb * K + C) * 2u; }
    const size_t kstep = (size_t)(BK * 2);
    const size_t hstep = (size_t)HALF * K * 2;
    const size_t tstep = 2 * hstep;
    const unsigned ldsw = (unsigned)wid * 1024u;
    const int aoff = lds_byte(wr * 64 + fr, fq * 8), boff = lds_byte(wc * 32 + fr, fq * 8);
#define PG8_SA(b, h) (((b) * 2 + (h)) * HTB)
#define PG8_SB(b, h) ((4 + (b) * 2 + (h)) * HTB)
#define PG8_STAGE(bufoff, gbase, voff) do { _Pragma("unroll") for (int _i = 0; _i < 2; ++_i) \
        __builtin_amdgcn_global_load_lds((const unsigned*)((const char*)(gbase) + (voff)[_i]), (PG8_LAS unsigned*)(lds + (bufoff) + ldsw + _i * 8192), 16, 0, 0); } while (0)
#define PG8_LDA(dst, b, h) do { _Pragma("unroll") for (int m = 0; m < 4; ++m) _Pragma("unroll") for (int k = 0; k < 2; ++k) dst[m][k] = *(const PG8_LAS bf16x8*)(lds + PG8_SA(b, h) + aoff + m * 2048 + k * 1024); } while (0)
#define PG8_LDB(dst, b, h) do { _Pragma("unroll") for (int n = 0; n < 2; ++n) _Pragma("unroll") for (int k = 0; k < 2; ++k) dst[n][k] = *(const PG8_LAS bf16x8*)(lds + PG8_SB(b, h) + boff + n * 2048 + k * 1024); } while (0)
#define PG8_MMA(ai, bj, At, Bt) do { __builtin_amdgcn_s_setprio(1); _Pragma("unroll") for (int m = 0; m < 4; ++m) _Pragma("unroll") for (int n = 0; n < 2; ++n) _Pragma("unroll") for (int k = 0; k < 2; ++k) \
        acc[ai][bj][m][n] = __builtin_amdgcn_mfma_f32_16x16x32_bf16(Bt[n][k], At[m][k], acc[ai][bj][m][n], 0, 0, 0); __builtin_amdgcn_s_setprio(0); } while (0)
#define PG8_WAIT_V(n) asm volatile("s_waitcnt vmcnt(" #n ")" ::: "memory")
#define PG8_WAIT_L(n) asm volatile("s_waitcnt lgkmcnt(" #n ")" ::: "memory")
#define PG8_BAR __builtin_amdgcn_s_barrier()
#define PG8_SCHED __builtin_amdgcn_sched_barrier(0)
    Unit cur, nxt; int ui = 0;
    if (!S.next(0, cur)) return;
    f32x4 acc[2][2][4][2];
#pragma unroll
    for (int a = 0; a < 2; ++a)
#pragma unroll
        for (int b = 0; b < 2; ++b)
#pragma unroll
            for (int m = 0; m < 4; ++m)
#pragma unroll
                for (int n = 0; n < 2; ++n) acc[a][b][m][n] = (f32x4){0.f, 0.f, 0.f, 0.f};
    bf16x8 At[4][2], B0[2][2], B1[2][2];
    const char* cA = (const char*)g.A + (size_t)cur.pm * tstep; const char* cB = (const char*)g.Bt + (size_t)cur.pn * tstep;
    S.a_ready(cur);
    PG8_STAGE(PG8_SB(0, 0), cB, voffB); PG8_STAGE(PG8_SA(0, 0), cA, voffA); PG8_STAGE(PG8_SB(0, 1), cB + hstep, voffB); PG8_STAGE(PG8_SA(0, 1), cA + hstep, voffA);
    if (wr == 1) PG8_BAR;
    PG8_WAIT_V(4); PG8_BAR;
    PG8_STAGE(PG8_SB(1, 0), cB + kstep, voffB); PG8_STAGE(PG8_SA(1, 0), cA + kstep, voffA); PG8_STAGE(PG8_SB(1, 1), cB + hstep + kstep, voffB);
    PG8_WAIT_V(6); PG8_BAR;
    PG8_STAMP();
    for (;;) {
        const bool has_next = S.next(ui + 1, nxt);
        const char* nA = has_next ? (const char*)g.A + (size_t)nxt.pm * tstep : cA; const char* nB = has_next ? (const char*)g.Bt + (size_t)nxt.pn * tstep : cB;
        for (int t = 0; t < nt; t += 2) {
            const bool last = (t == nt - 2);
            const char* a1 = cA + (size_t)(t + 1) * kstep;
            const char* a2 = last ? nA : cA + (size_t)(t + 2) * kstep; const char* b2 = last ? nB : cB + (size_t)(t + 2) * kstep;
            const char* a3 = a2 + kstep; const char* b3 = b2 + kstep;
            if (last && has_next) S.a_ready(nxt);
            PG8_LDB(B0, 0, 0); PG8_SCHED; PG8_LDA(At, 0, 0); PG8_STAGE(PG8_SA(1, 1), a1 + hstep, voffA);
            PG8_WAIT_L(8); PG8_BAR; PG8_WAIT_L(0); PG8_MMA(0, 0, At, B0); PG8_BAR; PG8_SCHED;
            PG8_LDB(B1, 0, 1); PG8_STAGE(PG8_SB(0, 0), b2, voffB);
            PG8_BAR; PG8_WAIT_L(0); PG8_MMA(0, 1, At, B1); PG8_BAR;
            PG8_LDA(At, 0, 1); PG8_STAGE(PG8_SA(0, 0), a2, voffA);
            PG8_BAR; PG8_WAIT_L(0); PG8_MMA(1, 0, At, B0); PG8_BAR; PG8_SCHED;
            PG8_STAGE(PG8_SB(0, 1), b2 + hstep, voffB);
            PG8_WAIT_V(6); PG8_BAR; PG8_MMA(1, 1, At, B1); PG8_BAR;
            PG8_LDB(B0, 1, 0); PG8_SCHED; PG8_LDA(At, 1, 0); PG8_STAGE(PG8_SA(0, 1), a2 + hstep, voffA);
            PG8_WAIT_L(8); PG8_BAR; PG8_WAIT_L(0); PG8_MMA(0, 0, At, B0); PG8_BAR; PG8_SCHED;
            PG8_LDB(B1, 1, 1); PG8_STAGE(PG8_SB(1, 0), b3, voffB);
            PG8_BAR; PG8_WAIT_L(0); PG8_MMA(0, 1, At, B1); PG8_BAR;
            PG8_LDA(At, 1, 1); PG8_STAGE(PG8_SA(1, 0), a3, voffA);
            PG8_BAR; PG8_WAIT_L(0); PG8_MMA(1, 0, At, B0); PG8_BAR; PG8_SCHED;
            PG8_STAGE(PG8_SB(1, 1), b3 + hstep, voffB);
            PG8_WAIT_V(6); PG8_BAR; PG8_MMA(1, 1, At, B1); PG8_BAR;
        }
        PG8_STAMP();
        if constexpr (!Epi::AFTER_DRAIN) { E(acc, cur, wr, wc, fr, fq); S.done(cur); }
        PG8_STAMP();
        if (!has_next) break;
#pragma unroll
        for (int a = 0; a < 2; ++a)
#pragma unroll
            for (int b = 0; b < 2; ++b)
#pragma unroll
                for (int m = 0; m < 4; ++m)
#pragma unroll
                    for (int n = 0; n < 2; ++n) acc[a][b][m][n] = (f32x4){0.f, 0.f, 0.f, 0.f};
        cur = nxt; cA = nA; cB = nB; ++ui;
    }
    PG8_WAIT_V(0);
    if (wr == 0) PG8_BAR;
    PG8_BAR;
    if constexpr (Epi::AFTER_DRAIN) { E.fused(acc, cur, wr, wc, fr, fq, lds, wid, lane); S.done(cur); }
    PG8_STAMP();
    if (STAMP && wid == 0) { stamps[lane] = lane < nts ? (((unsigned long long)(unsigned)ts_hi << 32) | (unsigned)ts_lo) : 0ull;
        if (lane == 62) stamps[62] = rt_entry; if (lane == 63) stamps[63] = (unsigned long long)wall_clock64(); }
#undef PG8_STAMP
#undef PG8_SA
#undef PG8_SB
#undef PG8_STAGE
#undef PG8_LDA
#undef PG8_LDB
#undef PG8_MMA
#undef PG8_WAIT_V
#undef PG8_WAIT_L
#undef PG8_BAR
#undef PG8_SCHED
}
}

namespace cg = cooperative_groups;
typedef unsigned short bf16_t;
typedef short bf16x8 __attribute__((ext_vector_type(8)));
typedef short bf16x4 __attribute__((ext_vector_type(4)));
typedef float f32x4 __attribute__((ext_vector_type(4)));
typedef unsigned u32x4 __attribute__((ext_vector_type(4)));
typedef unsigned u32x2 __attribute__((ext_vector_type(2)));

constexpr int NB = 4, SEQ = 8192, DM = 1024, MTOK = NB * SEQ;
constexpr int LDH0 = 3072, LDH1 = 2560;
constexpr int N0PAD = 3328;
constexpr float LN_EPS = 1e-5f;
constexpr float DN_ALPHA = 1.41421356237f;
constexpr int LDS_BYTES = 140 * 1024;

constexpr size_t WS_W0T = 0;
constexpr size_t WS_WO0T = WS_W0T + (size_t)N0PAD * 1024 * 2;
constexpr size_t WS_W1T = WS_WO0T + (size_t)1024 * 1024 * 2;
constexpr size_t WS_WO1T = WS_W1T + (size_t)2560 * 1024 * 2;
constexpr size_t WS_COS = WS_WO1T + (size_t)1024 * 1024 * 2;
constexpr size_t WS_SIN = WS_COS + (size_t)MTOK * 32 * 4;
constexpr size_t WS_ALR = WS_SIN + (size_t)MTOK * 32 * 4;
constexpr size_t WS_DEC = WS_ALR + (size_t)MTOK * 16 * 4;
constexpr size_t WS_XB = WS_DEC + (size_t)16 * 128 * 64 * 4;
constexpr size_t WS_H = WS_XB + (size_t)MTOK * 1024 * 2;
constexpr size_t WS_UT = WS_H + (size_t)MTOK * LDH0 * 2;
constexpr size_t WS_ST = WS_UT + (size_t)16 * 128 * 128 * 64 * 4;
constexpr size_t WS_MIX = WS_ST + (size_t)16 * 128 * 128 * 64 * 2;
constexpr size_t WS_BAR = WS_MIX + (size_t)MTOK * 1024 * 2;
constexpr size_t WS_END = WS_BAR + 16384;

struct Params { const float* in[20]; float* out; unsigned char* ws; };

__device__ __forceinline__ float bf2f(bf16_t b) { return __uint_as_float(((unsigned)b) << 16); }
__device__ __forceinline__ bf16_t f2bf(float f) { unsigned u = __float_as_uint(f); u += 0x7FFFu + ((u >> 16) & 1u); return (bf16_t)(u >> 16); }
__device__ __forceinline__ unsigned pk2(float lo, float hi) { unsigned r; asm("v_cvt_pk_bf16_f32 %0, %1, %2" : "=v"(r) : "v"(lo), "v"(hi)); return r; }
__device__ __forceinline__ float lo16(unsigned w) { return __uint_as_float(w << 16); }
__device__ __forceinline__ float hi16(unsigned w) { return __uint_as_float(w & 0xffff0000u); }
__device__ __forceinline__ float silu_f(float x) { return x * __builtin_amdgcn_rcpf(1.0f + __expf(-x)); }
__device__ __forceinline__ float gelu_f(float x) { const float u = 1.5957691216f * (x + 0.044715f * x * x * x); return x * __builtin_amdgcn_rcpf(1.0f + __expf(-u)); }
__device__ __forceinline__ unsigned lds_addr(const void* p) { return (unsigned)(size_t)p; }
__device__ __forceinline__ float wave_sum(float v) {
#pragma unroll
    for (int o = 32; o >= 1; o >>= 1) v += __shfl_xor(v, o);
    return v;
}
__device__ __forceinline__ bf16x8 lds_tr_frag(unsigned base, int stride, int k0, int col0, int lane) {
    const int g = lane >> 4, q = (lane & 15) >> 2, p = lane & 3;
    const unsigned a0 = base + (unsigned)((k0 + 8 * g + q) * stride + (col0 + 4 * p) * 2);
    const unsigned a1 = a0 + (unsigned)(4 * stride);
    bf16x4 lo, hi;
    asm volatile("ds_read_b64_tr_b16 %0, %2\n\tds_read_b64_tr_b16 %1, %3\n\ts_waitcnt lgkmcnt(0)" : "=&v"(lo), "=&v"(hi) : "v"(a0), "v"(a1) : "memory");
    return (bf16x8){lo[0], lo[1], lo[2], lo[3], hi[0], hi[1], hi[2], hi[3]};
}
#define MFMA16(a, b, c) __builtin_amdgcn_mfma_f32_16x16x32_bf16((a), (b), (c), 0, 0, 0)

struct EpiH0 {
    static constexpr bool PERM = true, AFTER_DRAIN = false;
    bf16_t* H; float* ALR;
    __device__ __forceinline__ void operator()(const pg8::f32x4 (&acc)[2][2][4][2], const pg8::Unit& u, int wr, int wc, int fr, int fq) const {
        const int row0 = u.pm * 256 + wr * 64 + fr;
        if (u.pn == 12) {
            if (wc == 0 && fq < 2) {
#pragma unroll
                for (int ai = 0; ai < 2; ++ai)
#pragma unroll
                    for (int m = 0; m < 4; ++m) { float* rp = ALR + (size_t)(row0 + ai * 128 + m * 16) * 16 + 8 * fq;
                        *(f32x4*)rp = acc[ai][0][m][0]; *(f32x4*)(rp + 4) = acc[ai][0][m][1]; }
            }
            return;
        }
        const int act = (u.pn < 4) ? 0 : ((u.pn < 6 || u.pn >= 10) ? 1 : 2);
        const int col0 = u.pn * 256 + wc * 32 + 8 * fq;
#pragma unroll
        for (int ai = 0; ai < 2; ++ai)
#pragma unroll
            for (int m = 0; m < 4; ++m) { bf16_t* rowp = H + (size_t)(row0 + ai * 128 + m * 16) * LDH0 + col0;
#pragma unroll
                for (int bj = 0; bj < 2; ++bj) { f32x4 v0 = acc[ai][bj][m][0], v1 = acc[ai][bj][m][1];
                    if (act == 1) {
#pragma unroll
                        for (int j = 0; j < 4; ++j) { v0[j] = silu_f(v0[j]); v1[j] = silu_f(v1[j]); } }
                    else if (act == 2) {
#pragma unroll
                        for (int j = 0; j < 4; ++j) { v0[j] = gelu_f(v0[j]); v1[j] = gelu_f(v1[j]); } }
                    u32x4 w; w.x = pk2(v0[0], v0[1]); w.y = pk2(v0[2], v0[3]); w.z = pk2(v1[0], v1[1]); w.w = pk2(v1[2], v1[3]);
                    *(u32x4*)(rowp + bj * 128) = w; } }
    }
};
struct EpiH1 {
    static constexpr bool PERM = true, AFTER_DRAIN = false;
    bf16_t* H; const float* COS; const float* SIN;
    __device__ __forceinline__ void operator()(const pg8::f32x4 (&acc)[2][2][4][2], const pg8::Unit& u, int wr, int wc, int fr, int fq) const {
        const int row0 = u.pm * 256 + wr * 64 + fr;
        if (u.pn < 2) {
            const float sc = (u.pn == 0) ? 0.125f : 1.0f;
            const int d0 = 16 * (wc & 1) + 4 * fq;
#pragma unroll
            for (int ai = 0; ai < 2; ++ai)
#pragma unroll
                for (int m = 0; m < 4; ++m) { const int row = row0 + ai * 128 + m * 16;
                    const f32x4 cs = *(const f32x4*)(COS + (size_t)row * 32 + d0), sn = *(const f32x4*)(SIN + (size_t)row * 32 + d0);
#pragma unroll
                    for (int bj = 0; bj < 2; ++bj) { const int hh = 2 * bj + (wc >> 1);
                        const f32x4 x1 = acc[ai][bj][m][0] * sc, x2 = acc[ai][bj][m][1] * sc;
                        const f32x4 y1 = x1 * cs - x2 * sn, y2 = x1 * sn + x2 * cs;
                        bf16_t* p = H + (size_t)row * LDH1 + u.pn * 256 + 64 * hh + d0;
                        u32x2 a, b; a.x = pk2(y1[0], y1[1]); a.y = pk2(y1[2], y1[3]); b.x = pk2(y2[0], y2[1]); b.y = pk2(y2[2], y2[3]);
                        *(u32x2*)p = a; *(u32x2*)(p + 32) = b; } }
            return;
        }
        const bool act = (u.pn == 4 || u.pn == 5 || u.pn >= 8);
        const int col0 = u.pn * 256 + wc * 32 + 8 * fq;
#pragma unroll
        for (int ai = 0; ai < 2; ++ai)
#pragma unroll
            for (int m = 0; m < 4; ++m) { bf16_t* rowp = H + (size_t)(row0 + ai * 128 + m * 16) * LDH1 + col0;
#pragma unroll
                for (int bj = 0; bj < 2; ++bj) { f32x4 v0 = acc[ai][bj][m][0], v1 = acc[ai][bj][m][1];
                    if (act) {
#pragma unroll
                        for (int j = 0; j < 4; ++j) { v0[j] = silu_f(v0[j]); v1[j] = silu_f(v1[j]); } }
                    u32x4 w; w.x = pk2(v0[0], v0[1]); w.y = pk2(v0[2], v0[3]); w.z = pk2(v1[0], v1[1]); w.w = pk2(v1[2], v1[3]);
                    *(u32x4*)(rowp + bj * 128) = w; } }
    }
};

__device__ __forceinline__ int srcmap(int which, int c) {
    if (which == 0) { if (c < 1536) return c; if (c < 3072) return c + 16; if (c < 3088) return 1536 + (c - 3072); return -1; }
    if (which == 2) { if (c < 512) { const int s = c & 63; return (c & ~63) + 4 * (s >> 3) + (s & 3) + 32 * ((s >> 2) & 1); } return c; }
    return c;
}
__device__ __forceinline__ void transpose_item(const float* W, int Nsrc, bf16_t* WT, int which, int item, int ntn, float* scr, int tid) {
    const int kt = item / ntn, nt = item % ntn, k0 = kt * 64, n0 = nt * 64;
    { const int nn = tid & 63; const int src = srcmap(which, n0 + nn);
      for (int kk = tid >> 6; kk < 64; kk += 8) scr[kk * 65 + nn] = (src >= 0) ? W[(size_t)(k0 + kk) * Nsrc + src] : 0.f; }
    __syncthreads();
    { const int kk = tid & 63;
      for (int nn = tid >> 6; nn < 64; nn += 8) WT[(size_t)(n0 + nn) * 1024 + k0 + kk] = f2bf(scr[kk * 65 + nn]); }
    __syncthreads();
}
__device__ __forceinline__ void p0_prologue(const Params& p, unsigned char* smem, int tid) {
    unsigned char* ws = p.ws; float* scr = (float*)smem;
    constexpr int I0 = 16 * (N0PAD / 64), I1 = 16 * 16, I2 = 16 * (2560 / 64), I3 = 16 * 16;
    for (int it = blockIdx.x; it < I0 + I1 + I2 + I3; it += gridDim.x) {
        int r = it;
        if (r < I0) { transpose_item(p.in[2], 3088, (bf16_t*)(ws + WS_W0T), 0, r, N0PAD / 64, scr, tid); continue; } r -= I0;
        if (r < I1) { transpose_item(p.in[10], 1024, (bf16_t*)(ws + WS_WO0T), 1, r, 16, scr, tid); continue; } r -= I1;
        if (r < I2) { transpose_item(p.in[13], 2560, (bf16_t*)(ws + WS_W1T), 2, r, 40, scr, tid); continue; } r -= I2;
        transpose_item(p.in[17], 1024, (bf16_t*)(ws + WS_WO1T), 3, r, 16, scr, tid);
    }
    const int gtid = blockIdx.x * 512 + tid, nthr = gridDim.x * 512;
    { const float4* x4 = (const float4*)p.in[0]; u32x4* xb = (u32x4*)(ws + WS_XB);
      for (int i = gtid; i < MTOK * DM / 8; i += nthr) { const float4 a = x4[2 * i], b = x4[2 * i + 1];
          u32x4 w; w.x = pk2(a.x, a.y); w.y = pk2(a.z, a.w); w.z = pk2(b.x, b.y); w.w = pk2(b.z, b.w); xb[i] = w; } }
    { const int* pos = (const int*)p.in[1]; float* C = (float*)(ws + WS_COS); float* Sn = (float*)(ws + WS_SIN);
      for (int i = gtid; i < MTOK * 32; i += nthr) { const int tok = i >> 5, ii = i & 31;
          const float inv = powf(10000.0f, -(float)ii / 32.0f); const float ang = (float)pos[tok] * inv;
          C[i] = cosf(ang); Sn[i] = sinf(ang); } }
}

template <int C, int NH>
__device__ __forceinline__ void state_mma(unsigned KSa, unsigned VSa, float* UTblk  , int NCH, int pr0, int n, int w, int lane) {
    constexpr int WPH = 8 / NH, EPW = 128 / WPH, MT = EPW / 16, KST = C / 32, VSTR = (NH * 128 + 8) * 2;
    const int hh = w / WPH, eq = w % WPH, g = lane >> 4, l15 = lane & 15;
    bf16x8 Bf[4][KST];
#pragma unroll
    for (int nt = 0; nt < 4; ++nt)
#pragma unroll
        for (int ks = 0; ks < KST; ++ks) Bf[nt][ks] = lds_tr_frag(KSa + hh * (C * 144), 144, 32 * ks, 16 * nt, lane);
    float* UTp = UTblk + ((size_t)((pr0 + hh) * NCH + n) * 128 + EPW * eq) * 64 + (4 * g) * 64 + l15;
#pragma unroll
    for (int mt = 0; mt < MT; ++mt) {
        asm volatile("" ::: "memory");
        bf16x8 Af[KST];
#pragma unroll
        for (int ks = 0; ks < KST; ++ks) Af[ks] = lds_tr_frag(VSa, VSTR, 32 * ks, hh * 128 + EPW * eq + 16 * mt, lane);
#pragma unroll
        for (int nt = 0; nt < 4; ++nt) { f32x4 a = (f32x4){0.f, 0.f, 0.f, 0.f};
#pragma unroll
            for (int ks = 0; ks < KST; ++ks) a = MFMA16(Af[ks], Bf[nt][ks], a);
#pragma unroll
            for (int r = 0; r < 4; ++r) UTp[(16 * mt + r) * 64 + 16 * nt] = a[r]; }
    }
}

__device__ __forceinline__ void gla_prep_task(const Params& p, int task, unsigned char* smem, int tid, bool dummy = false) {
    unsigned char* ws = p.ws; bf16_t* H = (bf16_t*)(ws + WS_H);
    const int lane = tid & 63, w = tid >> 6;
    const int tok0 = task * 64, b = task >> 7, n = task & 127;
    float* ALRs = (float*)smem; float* TOT = (float*)(smem + 4096); unsigned char* KS = smem + 8192; unsigned char* VS = smem + 8192 + 36864;
    float* LA = (float*)VS;
    if (tid < 256) ((float4*)ALRs)[tid] = ((const float4*)((const float*)(ws + WS_ALR) + (size_t)tok0 * 16))[tid];
    __syncthreads();
    const int h = w >> 1, th = w & 1, d = lane;
    {
        float wa[16];
#pragma unroll
        for (int r = 0; r < 16; ++r) wa[r] = p.in[3][r * 256 + h * 64 + d];
        const float ba = p.in[4][h * 64 + d];
        float run = 0.f;
#pragma unroll 4
        for (int jj = 0; jj < 32; ++jj) { const int j = 32 * th + jj; float z = ba;
#pragma unroll
            for (int r = 0; r < 16; ++r) z = fmaf(ALRs[j * 16 + r], wa[r], z);
            const float la = (fminf(z, 0.f) - __logf(1.0f + __expf(-fabsf(z)))) * 0.0625f; run += la; LA[j * 256 + h * 64 + d] = run; }
        TOT[w * 64 + d] = run;
    }
    __syncthreads();
    {
        const float t0 = TOT[(2 * h) * 64 + d], t1 = TOT[(2 * h + 1) * 64 + d]; const float total = t0 + t1, off = th ? t0 : 0.f;
        bf16_t* Hq = H + (size_t)(tok0 + 32 * th) * LDH0 + h * 64 + d;
#pragma unroll 4
        for (int jj = 0; jj < 32; ++jj) { const float bj = LA[(32 * th + jj) * 256 + h * 64 + d] + off; bf16_t* pq = Hq + (size_t)jj * LDH0; const float qv = bf2f(pq[0]), kv = bf2f(pq[256]);
            if (!dummy) { pq[0] = f2bf(qv * 0.125f * __expf(bj)); pq[256] = f2bf(kv * __expf(-bj)); }
            *(bf16_t*)(KS + h * 9216 + (32 * th + jj) * 144 + d * 2) = f2bf(kv * __expf(total - bj)); }
        if (th == 0) ((float*)(ws + WS_DEC))[((size_t)(b * 4 + h) * 128 + n) * 64 + d] = __expf(total);
    }
    __syncthreads();
#pragma unroll
    for (int i = 0; i < 8; ++i) { const int id = tid + 512 * i, row = id >> 6, ch = id & 63;
        *(u32x4*)(VS + row * 1040 + ch * 16) = *(const u32x4*)(H + (size_t)(tok0 + row) * LDH0 + 512 + ch * 8); }
    __syncthreads();
    state_mma<64, 4>(lds_addr(KS), lds_addr(VS), (float*)(ws + WS_UT), 128, b * 4, n, w, lane);
    __syncthreads();
}

__device__ __forceinline__ void sgu_phase(const Params& p, unsigned char* smem, int tid) {
    unsigned char* ws = p.ws; const bf16_t* H = (const bf16_t*)(ws + WS_H); bf16_t* MIX = (bf16_t*)(ws + WS_MIX);
    const int lane = tid & 63, w = tid >> 6, g16 = lane >> 4, l15 = lane & 15;
    const int grp = blockIdx.x & 3;
    unsigned char* WM = smem; unsigned char* SVs = smem + 34816;
    for (int id = tid; id < 4096; id += 512) { const int row = id >> 5, c4 = id & 31;
        const float4 v = *(const float4*)(p.in[8] + (size_t)grp * 16384 + row * 128 + 4 * c4); const int s = 4 * c4;
        u32x2 o; o.x = pk2(s <= row ? v.x : 0.f, s + 1 <= row ? v.y : 0.f); o.y = pk2(s + 2 <= row ? v.z : 0.f, s + 3 <= row ? v.w : 0.f);
        *(u32x2*)(WM + row * 272 + c4 * 8) = o; }
    for (int task = blockIdx.x; task < 1024; task += gridDim.x) {
        const int bc = task >> 2, tok0 = bc * 128;
        { const int row = tid >> 2, q = tid & 3; const bf16_t* src = H + (size_t)(tok0 + row) * LDH0 + 2048 + grp * 128 + 32 * q;
          float v[32];
#pragma unroll
          for (int i = 0; i < 4; ++i) { const u32x4 t = *(const u32x4*)(src + 8 * i);
              v[8 * i + 0] = lo16(t.x); v[8 * i + 1] = hi16(t.x); v[8 * i + 2] = lo16(t.y); v[8 * i + 3] = hi16(t.y);
              v[8 * i + 4] = lo16(t.z); v[8 * i + 5] = hi16(t.z); v[8 * i + 6] = lo16(t.w); v[8 * i + 7] = hi16(t.w); }
          float s1 = 0.f;
#pragma unroll
          for (int i = 0; i < 32; ++i) s1 += v[i];
          s1 += __shfl_xor(s1, 1); s1 += __shfl_xor(s1, 2);
          const float mu = s1 * (1.0f / 128.0f); float s2 = 0.f;
#pragma unroll
          for (int i = 0; i < 32; ++i) { v[i] -= mu; s2 += v[i] * v[i]; }
          s2 += __shfl_xor(s2, 1); s2 += __shfl_xor(s2, 2);
          const float rstd = __builtin_amdgcn_rsqf(s2 * (1.0f / 128.0f) + LN_EPS);
          const float* lg = p.in[6] + grp * 128 + 32 * q; const float* lb = p.in[7] + grp * 128 + 32 * q;
#pragma unroll
          for (int i = 0; i < 4; ++i) { float o[8];
#pragma unroll
              for (int j = 0; j < 8; ++j) o[j] = v[8 * i + j] * rstd * lg[8 * i + j] + lb[8 * i + j];
              u32x4 t; t.x = pk2(o[0], o[1]); t.y = pk2(o[2], o[3]); t.z = pk2(o[4], o[5]); t.w = pk2(o[6], o[7]);
              *(u32x4*)(SVs + row * 272 + (32 * q + 8 * i) * 2) = t; } }
        __syncthreads();
        { f32x4 acc[8];
#pragma unroll
          for (int nt = 0; nt < 8; ++nt) acc[nt] = (f32x4){0.f, 0.f, 0.f, 0.f};
          const unsigned SVa = lds_addr(SVs);
#pragma unroll
          for (int ks = 0; ks < 4; ++ks) if (ks <= (w >> 1)) {
              const bf16x8 Af = *(const bf16x8*)(WM + (16 * w + l15) * 272 + (32 * ks + 8 * g16) * 2);
#pragma unroll
              for (int nt = 0; nt < 8; ++nt) { const bf16x8 Bf = lds_tr_frag(SVa, 272, 32 * ks, 16 * nt, lane); acc[nt] = MFMA16(Bf, Af, acc[nt]); } }
          const int t = 16 * w + l15, tok = tok0 + t; const float bs = p.in[9][grp * 128 + t];
          const bf16_t* hr = H + (size_t)tok * LDH0 + grp * 128; bf16_t* mr = MIX + (size_t)tok * 1024 + 512 + grp * 128;
#pragma unroll
          for (int nt = 0; nt < 8; ++nt) { const int c = 16 * nt + 4 * g16;
              const u32x2 uu = *(const u32x2*)(hr + 1536 + c), gb = *(const u32x2*)(hr + 2560 + c);
              u32x2 o; o.x = pk2(lo16(uu.x) * (acc[nt][0] + bs) * lo16(gb.x), hi16(uu.x) * (acc[nt][1] + bs) * hi16(gb.x));
              o.y = pk2(lo16(uu.y) * (acc[nt][2] + bs) * lo16(gb.y), hi16(uu.y) * (acc[nt][3] + bs) * hi16(gb.y));
              *(u32x2*)(mr + c) = o; } }
        __syncthreads();
    }
}

template <int NCH, bool RET>
__device__ __forceinline__ void scan_phase(const Params& p, int tid) {
    unsigned char* ws = p.ws; const float* UT = (const float*)(ws + WS_UT); const float* DEC = (const float*)(ws + WS_DEC); bf16_t* ST = (bf16_t*)(ws + WS_ST);
    for (int e = blockIdx.x * 512 + tid; e < 16 * 8192; e += gridDim.x * 512) {
        const int pr = e >> 13, rem = e & 8191, d = rem & 63;
        const float decc = RET ? __expf(128.0f * __logf(1.0f - exp2f(-5.0f - (float)(pr & 3)))) : 0.f;
        const float* up = UT + (size_t)pr * NCH * 8192 + rem; const float* dp = DEC + (size_t)pr * NCH * 64 + d; bf16_t* sp = ST + (size_t)pr * NCH * 8192 + rem;
        float s = 0.f;
        for (int n0 = 0; n0 < NCH; n0 += 8) { float u[8], dc[8];
#pragma unroll
            for (int i = 0; i < 8; ++i) { u[i] = up[(size_t)(n0 + i) * 8192]; dc[i] = RET ? decc : dp[(n0 + i) * 64]; }
#pragma unroll
            for (int i = 0; i < 8; ++i) { sp[(size_t)(n0 + i) * 8192] = f2bf(s); s = dc[i] * s + u[i]; } }
    }
}

template <int C, int NH, bool RET, int LDH>
__device__ __forceinline__ void chunk_out_task(const Params& p, int task, unsigned char* smem, int tid, const float* normg) {
    constexpr int WPH = 8 / NH, NHP = 4 / NH, NCH = SEQ / C, VSTR = (NH * 128 + 8) * 2, PSTR = (C + 8) * 2, VBYTES = C * VSTR, NJT = C / 16, CPR = NH * 16;
    unsigned char* ws = p.ws; const bf16_t* H = (const bf16_t*)(ws + WS_H); bf16_t* MIX = (bf16_t*)(ws + WS_MIX);
    const int lane = tid & 63, w = tid >> 6, g = lane >> 4, l15 = lane & 15;
    const int hp = task % NHP, bc = task / NHP, tok0 = bc * C, b = bc / NCH, n = bc % NCH;
    unsigned char* VS = smem; unsigned char* Pw = smem + VBYTES + w * (32 * PSTR);
    for (int id = tid; id < C * CPR; id += 512) { const int row = id / CPR, ch = id % CPR;
        *(u32x4*)(VS + row * VSTR + ch * 16) = *(const u32x4*)(H + (size_t)(tok0 + row) * LDH + 512 + hp * NH * 128 + ch * 8); }
    const int hh = w / WPH, rq = w % WPH, h = hp * NH + hh, pr = b * 4 + h, i0 = 32 * rq;
    const float lg2 = RET ? log2f(1.0f - exp2f(-5.0f - (float)h)) : 0.f;
    bf16x8 Qf[2][2];
#pragma unroll
    for (int mi = 0; mi < 2; ++mi)
#pragma unroll
        for (int ks = 0; ks < 2; ++ks) Qf[mi][ks] = *(const bf16x8*)(H + (size_t)(tok0 + i0 + 16 * mi + l15) * LDH + h * 64 + 32 * ks + 8 * g);
#pragma unroll
    for (int nj = 0; nj < NJT; ++nj) if (nj <= 2 * rq + 1) {
        const bf16_t* kp = H + (size_t)(tok0 + 16 * nj + l15) * LDH + 256 + h * 64 + 8 * g;
        const bf16x8 K0 = *(const bf16x8*)kp, K1 = *(const bf16x8*)(kp + 32);
#pragma unroll
        for (int mi = 0; mi < 2; ++mi) { f32x4 s = (f32x4){0.f, 0.f, 0.f, 0.f}; s = MFMA16(Qf[mi][0], K0, s); s = MFMA16(Qf[mi][1], K1, s);
#pragma unroll
            for (int r = 0; r < 4; ++r) { const int il = 16 * mi + 4 * g + r, i = i0 + il, j = 16 * nj + l15; float v = s[r];
                if (RET) v *= exp2f((float)(i - j) * lg2);
                if (j > i) v = 0.f;
                *(bf16_t*)(Pw + il * PSTR + j * 2) = f2bf(v); } }
        asm volatile("" ::: "memory");
    }
    __syncthreads();
    f32x4 acc[2][8];
#pragma unroll
    for (int mi = 0; mi < 2; ++mi)
#pragma unroll
        for (int nt = 0; nt < 8; ++nt) acc[mi][nt] = (f32x4){0.f, 0.f, 0.f, 0.f};
    { const bf16_t* STp = (const bf16_t*)(ws + WS_ST) + ((size_t)(pr * NCH + n) * 128) * 64;
#pragma unroll
      for (int nt = 0; nt < 8; ++nt) { const bf16_t* sp = STp + (16 * nt + l15) * 64 + 8 * g; const bf16x8 B0 = *(const bf16x8*)sp, B1 = *(const bf16x8*)(sp + 32);
#pragma unroll
          for (int mi = 0; mi < 2; ++mi) { acc[mi][nt] = MFMA16(B0, Qf[mi][0], acc[mi][nt]); acc[mi][nt] = MFMA16(B1, Qf[mi][1], acc[mi][nt]); }
          if (nt & 1) asm volatile("" ::: "memory"); } }
    if (RET) {
#pragma unroll
        for (int mi = 0; mi < 2; ++mi) { const float f = exp2f((float)(i0 + 16 * mi + l15 + 1) * lg2);
#pragma unroll
            for (int nt = 0; nt < 8; ++nt) acc[mi][nt] *= f; } }
    { const unsigned VSa = lds_addr(VS);
#pragma unroll
      for (int ks2 = 0; ks2 < WPH; ++ks2) if (ks2 <= rq) {
          bf16x8 Pf[2];
#pragma unroll
          for (int mi = 0; mi < 2; ++mi) Pf[mi] = *(const bf16x8*)(Pw + (16 * mi + l15) * PSTR + (32 * ks2 + 8 * g) * 2);
#pragma unroll
          for (int nt = 0; nt < 8; ++nt) { const bf16x8 Vf = lds_tr_frag(VSa, VSTR, 32 * ks2, hh * 128 + 16 * nt, lane);
#pragma unroll
              for (int mi = 0; mi < 2; ++mi) acc[mi][nt] = MFMA16(Vf, Pf[mi], acc[mi][nt]); } } }
#pragma unroll
    for (int mi = 0; mi < 2; ++mi) {
        float mu = 0.f;
        if (RET) { float s1 = 0.f;
#pragma unroll
            for (int nt = 0; nt < 8; ++nt) s1 += (acc[mi][nt][0] + acc[mi][nt][1]) + (acc[mi][nt][2] + acc[mi][nt][3]);
            s1 += __shfl_xor(s1, 16); s1 += __shfl_xor(s1, 32); mu = s1 * (1.0f / 128.0f); }
        float s2 = 0.f;
#pragma unroll
        for (int nt = 0; nt < 8; ++nt) { const f32x4 dlt = acc[mi][nt] - mu; s2 += (dlt[0] * dlt[0] + dlt[1] * dlt[1]) + (dlt[2] * dlt[2] + dlt[3] * dlt[3]); }
        s2 += __shfl_xor(s2, 16); s2 += __shfl_xor(s2, 32);
        const float rstd = __builtin_amdgcn_rsqf(s2 * (1.0f / 128.0f) + LN_EPS);
        const int tok = tok0 + i0 + 16 * mi + l15;
        const bf16_t* gp = H + (size_t)tok * LDH + 1024 + h * 128 + 4 * g; bf16_t* mp = MIX + (size_t)tok * 1024 + h * 128 + 4 * g; const float* ng = normg + h * 128 + 4 * g;
#pragma unroll
        for (int nt = 0; nt < 8; ++nt) { const u32x2 gt = *(const u32x2*)(gp + 16 * nt); const f32x4 gn = *(const f32x4*)(ng + 16 * nt); const f32x4 v = (acc[mi][nt] - mu) * rstd * gn;
            u32x2 o; o.x = pk2(v[0] * lo16(gt.x), v[1] * hi16(gt.x)); o.y = pk2(v[2] * lo16(gt.y), v[3] * hi16(gt.y));
            *(u32x2*)(mp + 16 * nt) = o; }
    }
    __syncthreads();
}

__device__ __forceinline__ void ret_state_task(const Params& p, int task, unsigned char* smem, int tid) {
    unsigned char* ws = p.ws; const bf16_t* H = (const bf16_t*)(ws + WS_H);
    const int lane = tid & 63, w = tid >> 6;
    const int hp = task & 1, bc = task >> 1, tok0 = bc * 128, b = bc >> 6, n = bc & 63;
    unsigned char* KS = smem; unsigned char* VS = smem + 36864;
#pragma unroll
    for (int i = 0; i < 4; ++i) { const int id = tid + 512 * i, row = id >> 4, ch = id & 15, hh = ch >> 3;
        const u32x4 t = *(const u32x4*)(H + (size_t)(tok0 + row) * LDH1 + 256 + hp * 128 + ch * 8);
        const float lg2 = log2f(1.0f - exp2f(-5.0f - (float)(hp * 2 + hh))); const float f = exp2f((float)(127 - row) * lg2);
        u32x4 o; o.x = pk2(lo16(t.x) * f, hi16(t.x) * f); o.y = pk2(lo16(t.y) * f, hi16(t.y) * f); o.z = pk2(lo16(t.z) * f, hi16(t.z) * f); o.w = pk2(lo16(t.w) * f, hi16(t.w) * f);
        *(u32x4*)(KS + hh * 18432 + row * 144 + (ch & 7) * 16) = o; }
#pragma unroll
    for (int i = 0; i < 8; ++i) { const int id = tid + 512 * i, row = id >> 5, ch = id & 31;
        *(u32x4*)(VS + row * 528 + ch * 16) = *(const u32x4*)(H + (size_t)(tok0 + row) * LDH1 + 512 + hp * 256 + ch * 8); }
    __syncthreads();
    state_mma<128, 2>(lds_addr(KS), lds_addr(VS), (float*)(ws + WS_UT), 64, b * 4 + hp * 2, n, w, lane);
    __syncthreads();
}

__device__ __forceinline__ void pool_phase(const Params& p, unsigned char* smem, int tid) {
    unsigned char* ws = p.ws; const bf16_t* H = (const bf16_t*)(ws + WS_H); bf16_t* MIX = (bf16_t*)(ws + WS_MIX);
    const int lane = tid & 63, w = tid >> 6, g16 = lane >> 4, l15 = lane & 15;
    const int grp = blockIdx.x & 3, win = 2 << grp;
    unsigned char* WP = smem; unsigned char* PT = smem + 34816; unsigned char* PL = smem + 34816 + 39168;
    for (int id = tid; id < 4096; id += 512) { const int row = id >> 5, c4 = id & 31;
        const float4 v = *(const float4*)(p.in[15] + (size_t)grp * 16384 + row * 128 + 4 * c4);
        u32x2 o; o.x = pk2(v.x, v.y); o.y = pk2(v.z, v.w); *(u32x2*)(WP + row * 272 + c4 * 8) = o; }
    for (int task = blockIdx.x; task < 1024; task += gridDim.x) {
        const int bc = task >> 2, tok0 = bc * 128, s0 = tok0 & (SEQ - 1);
        for (int id = tid; id < 144 * 16; id += 512) { const int row = id >> 4, ch = id & 15;
            u32x4 t = (u32x4){0u, 0u, 0u, 0u};
            if (!(row < 16 && s0 == 0)) t = *(const u32x4*)(H + (size_t)(tok0 - 16 + row) * LDH1 + 1536 + grp * 128 + ch * 8);
            *(u32x4*)(PT + row * 272 + ch * 16) = t; }
        __syncthreads();
        { const int c = tid & 127, tq = tid >> 7, ts = 32 * tq; const bf16_t* col = (const bf16_t*)PT + c;
          float sum = 0.f;
          for (int i = 1; i < win; ++i) sum += bf2f(col[(16 + ts - i) * 136]);
          for (int tt = 0; tt < 32; ++tt) { const int tl = ts + tt; const float cur = bf2f(col[(16 + tl) * 136]); sum += cur;
              const int cnt = min(s0 + tl + 1, win); const float pooled = sum / (float)cnt - cur;
              *((bf16_t*)PL + tl * 136 + c) = f2bf(pooled);
              sum -= bf2f(col[(16 + tl - win + 1) * 136]); } }
        __syncthreads();
        { f32x4 acc[8];
#pragma unroll
          for (int nt = 0; nt < 8; ++nt) acc[nt] = (f32x4){0.f, 0.f, 0.f, 0.f};
          const unsigned WPa = lds_addr(WP);
#pragma unroll
          for (int ks = 0; ks < 4; ++ks) {
              const bf16x8 Af = *(const bf16x8*)(PL + (16 * w + l15) * 272 + (32 * ks + 8 * g16) * 2);
#pragma unroll
              for (int nt = 0; nt < 8; ++nt) { const bf16x8 Bf = lds_tr_frag(WPa, 272, 32 * ks, 16 * nt, lane); acc[nt] = MFMA16(Bf, Af, acc[nt]); } }
          const int t = 16 * w + l15, tok = tok0 + t;
          const bf16_t* hr = H + (size_t)tok * LDH1 + 2048 + grp * 128; bf16_t* mr = MIX + (size_t)tok * 1024 + 512 + grp * 128; const float* sc = p.in[16] + grp * 128;
#pragma unroll
          for (int nt = 0; nt < 8; ++nt) { const int c = 16 * nt + 4 * g16; const u32x2 gd = *(const u32x2*)(hr + c); const f32x4 s4 = *(const f32x4*)(sc + c);
              u32x2 o; o.x = pk2(acc[nt][0] * s4[0] * lo16(gd.x), acc[nt][1] * s4[1] * hi16(gd.x)); o.y = pk2(acc[nt][2] * s4[2] * lo16(gd.y), acc[nt][3] * s4[3] * hi16(gd.y));
              *(u32x2*)(mr + c) = o; } }
        __syncthreads();
    }
}

template <bool L0>
__device__ __forceinline__ void ln_phase(const float* xin, const bf16_t* xb_in, const float* Y, const float* gam, const float* bet, float* out, bf16_t* XB, int tid) {
    const int lane = tid & 63, gw = blockIdx.x * 8 + (tid >> 6), nw = gridDim.x * 8;
    f32x4 gv[4], bv[4];
#pragma unroll
    for (int j = 0; j < 4; ++j) { gv[j] = ((const f32x4*)gam)[lane + 64 * j]; bv[j] = ((const f32x4*)bet)[lane + 64 * j]; }
    for (int row = gw; row < MTOK; row += nw) {
        const f32x4* yr = (const f32x4*)(Y + (size_t)row * DM);
        f32x4 v[4]; float s1 = 0.f;
#pragma unroll
        for (int j = 0; j < 4; ++j) {
            f32x4 xv;
            if (L0) xv = ((const f32x4*)(xin + (size_t)row * DM))[lane + 64 * j];
            else { const u32x2 t = ((const u32x2*)(xb_in + (size_t)row * DM))[lane + 64 * j]; xv = (f32x4){lo16(t.x), hi16(t.x), lo16(t.y), hi16(t.y)}; }
            v[j] = xv * DN_ALPHA + yr[lane + 64 * j]; s1 += (v[j][0] + v[j][1]) + (v[j][2] + v[j][3]); }
        const float mu = wave_sum(s1) * (1.0f / DM); float s2 = 0.f;
#pragma unroll
        for (int j = 0; j < 4; ++j) { v[j] = v[j] - mu; s2 += (v[j][0] * v[j][0] + v[j][1] * v[j][1]) + (v[j][2] * v[j][2] + v[j][3] * v[j][3]); }
        const float rstd = 1.0f / sqrtf(wave_sum(s2) * (1.0f / DM) + LN_EPS);
#pragma unroll
        for (int j = 0; j < 4; ++j) { const f32x4 o = v[j] * rstd * gv[j] + bv[j];
            if (L0) { u32x2 t; t.x = pk2(o[0], o[1]); t.y = pk2(o[2], o[3]); ((u32x2*)(XB + (size_t)row * DM))[lane + 64 * j] = t; }
            else ((f32x4*)(out + (size_t)row * DM))[lane + 64 * j] = o; }
    }
}

constexpr int PTAB_OFF = LDS_BYTES - 256;
__device__ __forceinline__ unsigned long long lds_u64_uniform(const unsigned char* smem, int i) {
    const unsigned long long v = *(const volatile PG8_LAS unsigned long long*)((const PG8_LAS unsigned char*)smem + PTAB_OFF + 8 * i);
    const unsigned lo = __builtin_amdgcn_readfirstlane((unsigned)v), hi = __builtin_amdgcn_readfirstlane((unsigned)(v >> 32));
    return ((unsigned long long)hi << 32) | lo;
}
__device__ __forceinline__ Params load_params(const unsigned char* smem, unsigned long long need) {
    Params q;
#pragma unroll
    for (int i = 0; i < 20; ++i) q.in[i] = ((need >> i) & 1ull) ? (const float*)lds_u64_uniform(smem, i) : nullptr;
    q.out = ((need >> 20) & 1ull) ? (float*)lds_u64_uniform(smem, 20) : nullptr;
    q.ws = (unsigned char*)lds_u64_uniform(smem, 21);
    return q;
}


#define XB_TMO      128
#define XB_XCNT(j)  (256  + 64 * (j))
#define XB_XSUB(j)  (1280 + 64 * (j))
#define XB_XGEN(j)  (2304 + 64 * (j))
#define XB_TOP      3328
#define XB_TOPGEN   3392
#define XCD_BAR_WORDS 3456
#define XB_SPIN_CAP (1u << 18)
__device__ __forceinline__ unsigned xb_ld(unsigned* p)              { return __hip_atomic_load(p, __ATOMIC_RELAXED, __HIP_MEMORY_SCOPE_AGENT); }
__device__ __forceinline__ unsigned xb_add(unsigned* p, unsigned v) { return __hip_atomic_fetch_add(p, v, __ATOMIC_RELAXED, __HIP_MEMORY_SCOPE_AGENT); }
__device__ __forceinline__ unsigned xb_xcc_id() { return (unsigned)__builtin_amdgcn_s_getreg((3 << 11) | 20) & 0xFu; }
#define XB_SPIN(cond, bar) do { unsigned _sp = 0; while (cond) { __builtin_amdgcn_s_sleep(1); \
    if ((++_sp & 255u) == 0u) { if (xb_ld(&(bar)[XB_TMO])) break; if (_sp > XB_SPIN_CAP) { atomicAdd(&(bar)[XB_TMO], 1u); break; } } } } while (0)
__device__ __forceinline__ void xcd_barrier_complete(unsigned* bar, unsigned x, unsigned& nloc, unsigned& nx) {
    const unsigned G = gridDim.x;
    unsigned sum, cnt, mine, sp = 0u;
    for (;;) {
        sum = 0u; cnt = 0u; mine = 0u;
#pragma unroll
        for (unsigned j = 0; j < 16; ++j) { const unsigned c = xb_ld(&bar[XB_XCNT(j)]); sum += c; cnt += (c > 0u) ? 1u : 0u; mine = (j == x) ? c : mine; }
        if (sum == G) break;
        __builtin_amdgcn_s_sleep(1);
        if ((++sp & 255u) == 0u) { if (xb_ld(&bar[XB_TMO])) break; if (sp > XB_SPIN_CAP) { atomicAdd(&bar[XB_TMO], 1u); break; } }
    }
    nloc = mine > 0u ? mine : 1u; nx = cnt > 0u ? cnt : 1u;
}
__device__ __forceinline__ void xcd_barrier(unsigned* bar, volatile PG8_LAS unsigned* st, bool leader) {
    asm volatile("s_waitcnt vmcnt(0)" ::: "memory");
    __syncthreads();
    if (leader) {
        const unsigned x = xb_xcc_id();
        __builtin_amdgcn_s_waitcnt(0);
        unsigned nloc = st[0], nx = st[1];
        if (nloc == 0u) { xcd_barrier_complete(bar, x, nloc, nx); st[0] = nloc; st[1] = nx; }
        const unsigned old = xb_add(&bar[XB_XSUB(x)], 1u);
        const unsigned gen = old / nloc;
        if (old + 1u == (gen + 1u) * nloc) {
            __builtin_amdgcn_fence(__ATOMIC_RELEASE, "agent");
            asm volatile("s_waitcnt vmcnt(0)" ::: "memory");
            const unsigned og = xb_add(&bar[XB_TOP], 1u);
            const unsigned tg = og / nx;
            if (og + 1u == (tg + 1u) * nx) xb_add(&bar[XB_TOPGEN], 1u);
            else XB_SPIN(xb_ld(&bar[XB_TOPGEN]) == tg, bar);
            __builtin_amdgcn_fence(__ATOMIC_ACQUIRE, "agent");
            xb_add(&bar[XB_XGEN(x)], 1u);
            asm volatile("s_waitcnt vmcnt(0)" ::: "memory");
        } else {
            XB_SPIN(xb_ld(&bar[XB_XGEN(x)]) == gen, bar);
            __builtin_amdgcn_fence(__ATOMIC_ACQUIRE, "agent");
            asm volatile("s_waitcnt vmcnt(0)" ::: "memory");
        }
    }
    __syncthreads();
}

__global__ void __launch_bounds__(512, 2) mega_fwd(Params p) {
    extern __shared__ __attribute__((aligned(16))) unsigned char smem[];
    cg::grid_group grid = cg::this_grid();
    const int wv = __builtin_amdgcn_readfirstlane(threadIdx.x >> 6);
    int tid;
    PG8_LAS unsigned char* lds3 = (PG8_LAS unsigned char*)smem;
    if (threadIdx.x == 0) {
        unsigned long long* tab = (unsigned long long*)(smem + PTAB_OFF);
#pragma unroll
        for (int i = 0; i < 20; ++i) tab[i] = (unsigned long long)p.in[i];
        tab[20] = (unsigned long long)p.out; tab[21] = (unsigned long long)p.ws;
        ((volatile PG8_LAS unsigned*)(lds3 + PTAB_OFF + 192))[0] = 0u; ((volatile PG8_LAS unsigned*)(lds3 + PTAB_OFF + 192))[1] = 0u;
    }
    if (blockIdx.x == 0) { unsigned* bar = (unsigned*)(p.ws + WS_BAR); for (int i = threadIdx.x; i < XCD_BAR_WORDS; i += 512) __hip_atomic_store(bar + i, 0u, __ATOMIC_RELAXED, __HIP_MEMORY_SCOPE_AGENT); }
    __syncthreads();
#define SEAM() do { int t_; asm volatile("v_mbcnt_lo_u32_b32 %0, -1, 0\n\tv_mbcnt_hi_u32_b32 %0, -1, %0" : "=v"(t_)); \
    xcd_barrier((unsigned*)((unsigned char*)lds_u64_uniform(smem, 21) + WS_BAR), (volatile PG8_LAS unsigned*)(lds3 + PTAB_OFF + 192), wv == 0 && t_ == 0); } while (0)
#ifndef PM
#define PM 0xFFFF
#endif
#ifndef RM
#define RM 0
#endif
#define BIT(i) (1ull << (i))
#define PH(k, need) asm volatile("v_mbcnt_lo_u32_b32 %0, -1, 0\n\tv_mbcnt_hi_u32_b32 %0, -1, %0" : "=v"(tid)); tid += wv * 64; for (int rep_ = 0; rep_ < (((RM >> (k)) & 1) ? 2 : 1); ++rep_) if ((PM >> (k)) & 1) { const Params q = load_params(smem, need); unsigned char* ws = q.ws; (void)ws;
#define WSP(T, off) ((T*)(ws + (off)))
    PH(0, BIT(0) | BIT(1) | BIT(2) | BIT(10) | BIT(13) | BIT(17)) p0_prologue(q, smem, tid); }
    grid.sync();
    if (threadIdx.x == 0) (void)xb_add((unsigned*)((unsigned char*)lds_u64_uniform(smem, 21) + WS_BAR) + XB_XCNT(xb_xcc_id()), 1u);
#ifdef XSYNC
    for (int xs = 0; xs < XSYNC; ++xs) SEAM();
#endif
    PH(1, 0) pg8::Gemm g{WSP(bf16_t, WS_XB), WSP(const bf16_t, WS_W0T), MTOK, N0PAD, DM}; pg8::StaticOrder So; So.init(MTOK, N0PAD, (int)gridDim.x, (int)blockIdx.x);
      EpiH0 E{WSP(bf16_t, WS_H), WSP(float, WS_ALR)}; pg8::gemm_phase<EpiH0, pg8::StaticOrder, false>(lds3, g, So, E, nullptr, tid); }
    SEAM();
    PH(2, BIT(3) | BIT(4)) for (int task = blockIdx.x; task < 512; task += gridDim.x) gla_prep_task(q, task, smem, tid, (RM >> 2) & 1 ? rep_ == 0 : false); }
    __syncthreads();
    PH(3, BIT(6) | BIT(7) | BIT(8) | BIT(9)) sgu_phase(q, smem, tid); }
    SEAM();
    PH(4, 0) scan_phase<128, false>(q, tid); }
    SEAM();
    PH(5, BIT(5)) for (int task = blockIdx.x; task < 512; task += gridDim.x) chunk_out_task<64, 4, false, LDH0>(q, task, smem, tid, q.in[5]); }
    SEAM();
    PH(6, 0) pg8::Gemm g{WSP(bf16_t, WS_MIX), WSP(const bf16_t, WS_WO0T), MTOK, DM, DM}; pg8::StaticOrder So; So.init(MTOK, DM, (int)gridDim.x, (int)blockIdx.x);
      pg8::EpiF32 E{WSP(float, WS_H), DM, nullptr}; pg8::gemm_phase<pg8::EpiF32, pg8::StaticOrder, false>(lds3, g, So, E, nullptr, tid); }
    SEAM();
    PH(7, BIT(0) | BIT(11) | BIT(12)) ln_phase<true>(q.in[0], nullptr, WSP(float, WS_H), q.in[11], q.in[12], nullptr, WSP(bf16_t, WS_XB), tid); }
    SEAM();
    PH(8, 0) pg8::Gemm g{WSP(bf16_t, WS_XB), WSP(const bf16_t, WS_W1T), MTOK, 2560, DM}; pg8::StaticOrder So; So.init(MTOK, 2560, (int)gridDim.x, (int)blockIdx.x);
      EpiH1 E{WSP(bf16_t, WS_H), WSP(const float, WS_COS), WSP(const float, WS_SIN)}; pg8::gemm_phase<EpiH1, pg8::StaticOrder, false>(lds3, g, So, E, nullptr, tid); }
    SEAM();
    PH(9, 0) for (int task = blockIdx.x; task < 512; task += gridDim.x) ret_state_task(q, task, smem, tid); }
    __syncthreads();
    PH(10, BIT(15) | BIT(16)) pool_phase(q, smem, tid); }
    SEAM();
    PH(11, 0) scan_phase<64, true>(q, tid); }
    SEAM();
    PH(12, BIT(14)) for (int task = blockIdx.x; task < 512; task += gridDim.x) chunk_out_task<128, 2, true, LDH1>(q, task, smem, tid, q.in[14]); }
    SEAM();
    PH(13, 0) pg8::Gemm g{WSP(bf16_t, WS_MIX), WSP(const bf16_t, WS_WO1T), MTOK, DM, DM}; pg8::StaticOrder So; So.init(MTOK, DM, (int)gridDim.x, (int)blockIdx.x);
      pg8::EpiF32 E{WSP(float, WS_H), DM, nullptr}; pg8::gemm_phase<pg8::EpiF32, pg8::StaticOrder, false>(lds3, g, So, E, nullptr, tid); }
    SEAM();
    PH(14, BIT(18) | BIT(19) | BIT(20)) ln_phase<false>(nullptr, WSP(const bf16_t, WS_XB), WSP(float, WS_H), q.in[18], q.in[19], q.out, nullptr, tid); }
}

extern "C" void kernel_launch(void* const* d_in, const int* in_sizes, int n_in, void* d_out, int out_size, void* d_ws, size_t ws_size, hipStream_t stream) {
    static int grid_blocks = 0;
    if (grid_blocks == 0) {
        if (n_in != 20 || ws_size < WS_END) { fprintf(stderr, "kernel_launch: unexpected n_in %d or ws_size %zu (need %zu)\n", n_in, ws_size, (size_t)WS_END); grid_blocks = -1; return; }
        int dev = 0, cus = 0, per_cu = 0;
        hipGetDevice(&dev);
        hipDeviceGetAttribute(&cus, hipDeviceAttributeMultiprocessorCount, dev);
        if (hipFuncSetAttribute((const void*)mega_fwd, hipFuncAttributeMaxDynamicSharedMemorySize, LDS_BYTES) != hipSuccess) { fprintf(stderr, "kernel_launch: hipFuncSetAttribute failed\n"); grid_blocks = -1; return; }
        if (hipOccupancyMaxActiveBlocksPerMultiprocessor(&per_cu, (const void*)mega_fwd, 512, LDS_BYTES) != hipSuccess || per_cu < 1) { fprintf(stderr, "kernel_launch: occupancy query gave %d\n", per_cu); grid_blocks = -1; return; }
        grid_blocks = cus;
        grid_blocks &= ~7;
        if (grid_blocks < 8) { grid_blocks = -1; return; }
    }
    if (grid_blocks < 0) return;
    Params p{};
    for (int i = 0; i < 20; ++i) p.in[i] = (const float*)d_in[i];
    p.out = (float*)d_out; p.ws = (unsigned char*)d_ws;
    void* args[] = {&p};
    hipError_t e = hipLaunchCooperativeKernel((const void*)mega_fwd, dim3(grid_blocks), dim3(512), args, LDS_BYTES, stream);
    if (e != hipSuccess) fprintf(stderr, "cooperative launch failed: %s (grid %d)\n", hipGetErrorString(e), grid_blocks);
}
```
